# Optimizing an MI355X kernel written in HIP

```python
import math
import jax, jax.numpy as jnp
from jax import lax
import numpy as np

D_MODEL = 4096
BATCH = 4
SEQ = 2048
DEPTH = 1
DEC_BATCH = 128
DEC_SEQ = 8
PAST_LEN = 16384
PAGE_SIZE = 128

HM = 4
DK_M = 256
DV_M = 512
HR = 8
DK_R = 128
DV_R = 256
MIX = HM * DV_M + HR * DV_R
D_FF = 4 * D_MODEL
CHUNK = 64
GATE_SOFTCAP = 15.0
ROPE_BASE = 10000.0
EPS = 1e-6
COLS = (HM * DK_M, HM * DK_M, HM * DV_M, HM * DV_M, HM, HM,
        HR * DK_R, HR * DK_R, HR * DV_R, HR * DV_R)
IN_COLS = sum(COLS)

kernel_name = "hymba_mlstm_retention_decode_step"


def rmsnorm(x, g):
    x32 = x.astype(jnp.float32)
    y = x32 * lax.rsqrt(jnp.mean(x32 * x32, axis=-1, keepdims=True) + EPS)
    return (y * g.astype(jnp.float32)).astype(x.dtype)


def head_rmsnorm(h, g):
    y = h * lax.rsqrt(jnp.mean(h * h, axis=-1, keepdims=True) + EPS)
    return y * g.astype(jnp.float32)


def softcap(z):
    return GATE_SOFTCAP * jnp.tanh(z / GATE_SOFTCAP)


def rotary(x, pos):
    d = x.shape[-1]
    freqs = ROPE_BASE ** (-jnp.arange(0, d, 2, dtype=jnp.float32) / d)
    ang = pos[:, None] * freqs[None, :]
    cos = jnp.cos(ang)[None, :, None, :]
    sin = jnp.sin(ang)[None, :, None, :]
    x1, x2 = x[..., : d // 2], x[..., d // 2:]
    return jnp.concatenate([x1 * cos - x2 * sin, x1 * sin + x2 * cos], axis=-1)


def to_chunks(a, L):
    B, T = a.shape[:2]
    a = a.reshape((B, T // L, L) + a.shape[2:])
    if a.ndim == 5:
        return a.transpose(1, 0, 3, 2, 4)
    return a.transpose(1, 0, 3, 2)


def from_chunks(a):
    NC, B, H, L, d = a.shape
    return a.transpose(1, 0, 3, 2, 4).reshape(B, NC * L, H, d)


def mlstm_chunked(q, k, v, logi, logf, C0, n0, m0):
    T = q.shape[1]
    L = math.gcd(T, CHUNK)
    causal = jnp.tril(jnp.ones((L, L), dtype=bool))

    def step(carry, inp):
        C, n, m = carry
        qc, kc, vc, ic, fc = inp
        b = jnp.cumsum(fc, axis=-1)
        dlog = b[..., :, None] - b[..., None, :] + ic[..., None, :]
        dlog = jnp.where(causal, dlog, -jnp.inf)
        inter = b + m[..., None]
        mt = jnp.maximum(inter, jnp.max(dlog, axis=-1))
        dw = jnp.exp(dlog - mt[..., None])
        iw = jnp.exp(inter - mt)
        s = jnp.einsum('bhld,bhsd->bhls', qc, kc) * dw
        num = iw[..., None] * jnp.einsum('bhld,bhde->bhle', qc, C) + jnp.einsum('bhls,bhse->bhle', s, vc)
        den = iw * jnp.einsum('bhld,bhd->bhl', qc, n) + jnp.sum(s, axis=-1)
        h = num / jnp.maximum(jnp.abs(den), jnp.exp(-mt))[..., None]
        bL = b[..., -1]
        wlog = bL[..., None] - b + ic
        m_new = jnp.maximum(bL + m, jnp.max(wlog, axis=-1))
        decay = jnp.exp(bL + m - m_new)
        w = jnp.exp(wlog - m_new[..., None])
        C_new = decay[..., None, None] * C + jnp.einsum('bhs,bhsd,bhse->bhde', w, kc, vc)
        n_new = decay[..., None] * n + jnp.einsum('bhs,bhsd->bhd', w, kc)
        return (C_new, n_new, m_new), h

    xs = (to_chunks(q, L), to_chunks(k, L), to_chunks(v, L), to_chunks(logi, L), to_chunks(logf, L))
    (C, n, m), h = lax.scan(step, (C0, n0, m0), xs)
    return from_chunks(h), C, n, m


def retention_chunked(q, k, v, S0):
    T = q.shape[1]
    L = math.gcd(T, CHUNK)
    lg = jnp.log(1.0 - 2.0 ** (-5.0 - jnp.arange(HR, dtype=jnp.float32)))
    idx = jnp.arange(L, dtype=jnp.float32)
    diff = idx[:, None] - idx[None, :]
    dmat = jnp.where(diff >= 0, jnp.exp(jnp.maximum(diff, 0.0)[None] * lg[:, None, None]), 0.0)
    inter = jnp.exp((idx[None, :] + 1.0) * lg[:, None])
    kdec = jnp.exp((L - 1.0 - idx[None, :]) * lg[:, None])
    sdec = jnp.exp(L * lg)

    def step(S, inp):
        qc, kc, vc = inp
        s = jnp.einsum('bhld,bhsd->bhls', qc, kc) * dmat
        o = jnp.einsum('bhls,bhse->bhle', s, vc) + inter[..., None] * jnp.einsum('bhld,bhde->bhle', qc, S)
        S_new = sdec[:, None, None] * S + jnp.einsum('hs,bhsd,bhse->bhde', kdec, kc, vc)
        return S_new, o

    xs = (to_chunks(q, L), to_chunks(k, L), to_chunks(v, L))
    S, o = lax.scan(step, S0, xs)
    return from_chunks(o), S


def layer(x, C0, n0, m0, S0, pos0, w_in, b_igate, b_fgate, g_mlstm_head, g_ret_head,
          w_out, g_norm_mix, g_norm_ffn, w_up, w_down):
    B, T, _ = x.shape
    f32 = jnp.float32
    h = rmsnorm(x, g_norm_mix)
    proj = jnp.einsum('btd,dc->btc', h, w_in).astype(f32)
    splits = np.cumsum(COLS)[:-1].tolist()
    qm, km, vm, om, ig, fg, qr, kr, vr, gr = jnp.split(proj, splits, axis=-1)

    qm = qm.reshape(B, T, HM, DK_M) * (DK_M ** -0.5)
    km = km.reshape(B, T, HM, DK_M)
    vm = vm.reshape(B, T, HM, DV_M)
    logi = softcap(ig + b_igate.astype(f32))
    logf = jax.nn.log_sigmoid(softcap(fg + b_fgate.astype(f32)))
    hm, C, n, m = mlstm_chunked(qm, km, vm, logi, logf,
                                C0.astype(f32), n0.astype(f32), m0.astype(f32))
    hm = head_rmsnorm(hm, g_mlstm_head) * jax.nn.sigmoid(om.reshape(B, T, HM, DV_M))

    pos = jnp.arange(T, dtype=f32) + pos0
    qr = rotary(qr.reshape(B, T, HR, DK_R), pos)
    kr = rotary(kr.reshape(B, T, HR, DK_R), pos) * (DK_R ** -0.5)
    vr = vr.reshape(B, T, HR, DV_R)
    hr, S = retention_chunked(qr, kr, vr, S0.astype(f32))
    hr = head_rmsnorm(hr, g_ret_head) * jax.nn.silu(gr.reshape(B, T, HR, DV_R))

    cat = jnp.concatenate([hm.reshape(B, T, HM * DV_M), hr.reshape(B, T, HR * DV_R)], axis=-1)
    x = x + jnp.einsum('btc,cd->btd', cat.astype(x.dtype), w_out)

    u = jnp.einsum('btd,df->btf', rmsnorm(x, g_norm_ffn), w_up)
    x = x + jnp.einsum('btf,fd->btd', jnp.square(jax.nn.relu(u)), w_down)
    return x, C, n, m, S


def setup_inputs(seed: int = 0) -> dict:
    key = jax.random.key(seed)
    ks = jax.random.split(key, 20)
    nrm = jax.random.normal
    f32 = jnp.float32
    return {
        "x_prompt": nrm(ks[0], (BATCH, SEQ, D_MODEL), f32),
        "x_sample": nrm(ks[1], (DEC_BATCH, DEC_SEQ, D_MODEL), f32),
        "state_mlstm_C": 0.5 * nrm(ks[2], (DEPTH, DEC_BATCH, HM, DK_M, DV_M), f32),
        "state_mlstm_n": 0.5 * nrm(ks[3], (DEPTH, DEC_BATCH, HM, DK_M), f32),
        "state_mlstm_m": nrm(ks[4], (DEPTH, DEC_BATCH, HM), f32),
        "state_ret_S": 0.5 * nrm(ks[5], (DEPTH, DEC_BATCH, HR, DK_R, DV_R), f32),
        "w_in": nrm(ks[6], (DEPTH, D_MODEL, IN_COLS), f32) * D_MODEL ** -0.5,
        "b_igate": 0.1 * nrm(ks[7], (DEPTH, HM), f32),
        "b_fgate": jnp.linspace(3.0, 6.0, HM, dtype=f32)[None] + 0.1 * nrm(ks[8], (DEPTH, HM), f32),
        "g_mlstm_head": 1.0 + 0.02 * nrm(ks[9], (DEPTH, HM, DV_M), f32),
        "g_ret_head": 1.0 + 0.02 * nrm(ks[10], (DEPTH, HR, DV_R), f32),
        "w_out": nrm(ks[11], (DEPTH, MIX, D_MODEL), f32) * MIX ** -0.5,
        "g_norm_mix": 1.0 + 0.02 * nrm(ks[12], (DEPTH, D_MODEL), f32),
        "g_norm_ffn": 1.0 + 0.02 * nrm(ks[13], (DEPTH, D_MODEL), f32),
        "w_up": nrm(ks[14], (DEPTH, D_MODEL, D_FF), f32) * D_MODEL ** -0.5,
        "w_down": nrm(ks[15], (DEPTH, D_FF, D_MODEL), f32) * D_FF ** -0.5,
        "g_final": 1.0 + 0.02 * nrm(ks[16], (D_MODEL,), f32),
    }


def reference(x_prompt, x_sample, state_mlstm_C, state_mlstm_n, state_mlstm_m, state_ret_S,
              w_in, b_igate, b_fgate, g_mlstm_head, g_ret_head, w_out, g_norm_mix, g_norm_ffn,
              w_up, w_down, g_final):
    f32 = jnp.float32
    B = x_prompt.shape[0]
    yp, ys = x_prompt, x_sample
    pC, pn, pm, pS, sC, sn, sm, sS = [], [], [], [], [], [], [], []
    for l in range(DEPTH):
        w = (w_in[l], b_igate[l], b_fgate[l], g_mlstm_head[l], g_ret_head[l], w_out[l],
             g_norm_mix[l], g_norm_ffn[l], w_up[l], w_down[l])
        yp, c, n, m, s = layer(yp, jnp.zeros((B, HM, DK_M, DV_M), f32), jnp.zeros((B, HM, DK_M), f32),
                               jnp.zeros((B, HM), f32), jnp.zeros((B, HR, DK_R, DV_R), f32), 0.0, *w)
        pC.append(c); pn.append(n); pm.append(m); pS.append(s)
        ys, c, n, m, s = layer(ys, state_mlstm_C[l], state_mlstm_n[l], state_mlstm_m[l], state_ret_S[l],
                               float(PAST_LEN), *w)
        sC.append(c); sn.append(n); sm.append(m); sS.append(s)
    y_prompt = rmsnorm(yp, g_final)
    y_sample = rmsnorm(ys, g_final)
    return (y_prompt, y_sample,
            jnp.stack(pC), jnp.stack(pn), jnp.stack(pm), jnp.stack(pS),
            jnp.stack(sC), jnp.stack(sn), jnp.stack(sm), jnp.stack(sS))
```

```cpp
#include <hip/hip_runtime.h>
#include <cstdio>
#include <cstdint>
namespace pg8 {
#define PG8_LAS __attribute__((address_space(3)))
typedef unsigned short bf16_t;
typedef short bf16x8 __attribute__((ext_vector_type(8)));
typedef float f32x4 __attribute__((ext_vector_type(4)));
typedef unsigned u32x4 __attribute__((ext_vector_type(4)));
constexpr int BM = 256, BK = 64, HALF = 128, HTB = HALF * BK * 2  , STAGE_BYTES = 8 * HTB, NXCD = 8, WGM = 8;

__host__ __device__ __forceinline__ int lds_byte(int r, int c) { const int st = (r >> 4) * 2 + (c >> 5), rr = r & 15, cc = c & 31, ob = rr * 64 + cc * 2; return st * 1024 + (ob ^ (((ob >> 9) & 1) << 5)); }
__host__ __device__ __forceinline__ void stage_rc(int b, int& R, int& C) { const int st = b / 1024, sb = b % 1024, swz = sb ^ (((sb >> 9) & 1) << 5); R = (st >> 1) * 16 + swz / 64; C = (st & 1) * 32 + (swz % 64) / 2; }
__host__ __device__ __forceinline__ int perm32(int rho) { const int n = rho >> 4, i = rho & 15; return 8 * (i >> 2) + 4 * n + (i & 3); }

struct Unit { int pm, pn, k0; };
struct Gemm { const bf16_t* A; const bf16_t* Bt; int M, N, K, ld; };

struct StaticOrder {
    int nM, nN, nwg, G, c;
    __host__ __device__ void init(int M, int N, int G_, int c_) { nM = M / BM; nN = N / BM; nwg = nM * nN; G = G_; c = c_; }
    __host__ __device__ bool next(int i, Unit& u) const {
        const long L = (long)i * G + c; if (L >= nwg) return false;
        int wgid = (int)L; { const int q = nwg / NXCD, r = nwg % NXCD, xcd = wgid % NXCD, off = wgid / NXCD; wgid = (xcd < r ? xcd * (q + 1) : r * (q + 1) + (xcd - r) * q) + off; }
        const int nig = WGM * nN, gid = wgid / nig, fm = gid * WGM, gsz = (nM - fm) < WGM ? (nM - fm) : WGM;
        u.pm = fm + ((wgid % nig) % gsz); u.pn = (wgid % nig) / gsz; u.k0 = 0; return true;
    }
    __device__ __forceinline__ void a_ready(const Unit&) const {}
    __device__ __forceinline__ void done(const Unit&) const {}
};

typedef float f32x2_c __attribute__((ext_vector_type(2))); typedef __bf16 bf16x2_c __attribute__((ext_vector_type(2)));
__device__ __forceinline__ unsigned cvt_pk_bf16(float lo, float hi) { const f32x2_c v = {lo, hi}; const bf16x2_c b = __builtin_convertvector(v, bf16x2_c); return __builtin_bit_cast(unsigned, b); }

struct EpiProj {
    static constexpr bool PERM = true, AFTER_DRAIN = false;
    bf16_t* O; int ldc; float* gates; int gate_pn; int nscale; float sc0;
    __device__ __forceinline__ void operator()(const f32x4 (&acc)[2][2][4][2], const Unit& u, int wr, int wc, int fr, int fq) const {
        const int row0 = u.pm * BM + wr * 64 + fr;
        if (u.pn == gate_pn) {
            if (wc == 0 && fq == 0) {
#pragma unroll
                for (int ai = 0; ai < 2; ++ai)
#pragma unroll
                    for (int m = 0; m < 4; ++m) { float* g = gates + (size_t)(row0 + ai * HALF + m * 16) * 8; *(f32x4*)g = acc[ai][0][m][0]; *(f32x4*)(g + 4) = acc[ai][0][m][1]; }
            }
            return;
        }
        const float sc = (u.pn < nscale) ? sc0 : 1.f;
        const int col0 = u.pn * BM + wc * 32 + 8 * fq;
#pragma unroll
        for (int ai = 0; ai < 2; ++ai)
#pragma unroll
            for (int m = 0; m < 4; ++m) { bf16_t* rowp = O + (size_t)(row0 + ai * HALF + m * 16) * ldc + col0;
#pragma unroll
                for (int bj = 0; bj < 2; ++bj) { const f32x4 v0 = acc[ai][bj][m][0] * sc, v1 = acc[ai][bj][m][1] * sc;
                    u32x4 w; w.x = cvt_pk_bf16(v0[0], v0[1]); w.y = cvt_pk_bf16(v0[2], v0[3]); w.z = cvt_pk_bf16(v1[0], v1[1]); w.w = cvt_pk_bf16(v1[2], v1[3]);
                    *(u32x4*)(rowp + bj * HALF) = w; } }
    }
};
struct EpiRelu2 {
    static constexpr bool PERM = true, AFTER_DRAIN = false;
    bf16_t* O; int ldc;
    __device__ __forceinline__ void operator()(const f32x4 (&acc)[2][2][4][2], const Unit& u, int wr, int wc, int fr, int fq) const {
        const int row0 = u.pm * BM + wr * 64 + fr, col0 = u.pn * BM + wc * 32 + 8 * fq;
#pragma unroll
        for (int ai = 0; ai < 2; ++ai)
#pragma unroll
            for (int m = 0; m < 4; ++m) { bf16_t* rowp = O + (size_t)(row0 + ai * HALF + m * 16) * ldc + col0;
#pragma unroll
                for (int bj = 0; bj < 2; ++bj) { f32x4 v0 = acc[ai][bj][m][0], v1 = acc[ai][bj][m][1];
#pragma unroll
                    for (int j = 0; j < 4; ++j) { const float a = fmaxf(v0[j], 0.f), b = fmaxf(v1[j], 0.f); v0[j] = a * a; v1[j] = b * b; }
                    u32x4 w; w.x = cvt_pk_bf16(v0[0], v0[1]); w.y = cvt_pk_bf16(v0[2], v0[3]); w.z = cvt_pk_bf16(v1[0], v1[1]); w.w = cvt_pk_bf16(v1[2], v1[3]);
                    *(u32x4*)(rowp + bj * HALF) = w; } }
    }
};
struct EpiResF32 {
    static constexpr bool PERM = false, AFTER_DRAIN = false;
    const float* res_lo; const float* res_hi; int split_pm; float* C; int ldc;
    __device__ __forceinline__ void operator()(const f32x4 (&acc)[2][2][4][2], const Unit& u, int wr, int wc, int fr, int fq) const {
        const int row0 = u.pm * BM + wr * 64 + fr, col0 = u.pn * BM + wc * 32 + 4 * fq;
        const float* rb = (u.pm < split_pm) ? res_lo : res_hi - (size_t)split_pm * BM * ldc;
#pragma unroll
        for (int ai = 0; ai < 2; ++ai)
#pragma unroll
            for (int m = 0; m < 4; ++m) { const size_t off = (size_t)(row0 + ai * HALF + m * 16) * ldc + col0;
                f32x4 o[2][2];
#pragma unroll
                for (int bj = 0; bj < 2; ++bj)
#pragma unroll
                    for (int n = 0; n < 2; ++n) o[bj][n] = *(const f32x4*)(rb + off + bj * HALF + n * 16) + acc[ai][bj][m][n];
#pragma unroll
                for (int bj = 0; bj < 2; ++bj)
#pragma unroll
                    for (int n = 0; n < 2; ++n) *(f32x4*)(C + off + bj * HALF + n * 16) = o[bj][n];
                asm volatile("" ::: "memory"); }
    }
};

struct EpiX1 {
    static constexpr bool PERM = true, AFTER_DRAIN = false;
    const float* res; const float* g; bf16_t* X1; bf16_t* XN; int ldr, ldx; float* rowssq;
    __device__ __forceinline__ void operator()(const f32x4 (&acc)[2][2][4][2], const Unit& u, int wr, int wc, int fr, int fq) const {
        const int row0 = u.pm * BM + wr * 64 + fr, col0 = u.pn * BM + wc * 32 + 8 * fq;
        f32x4 gv[2][2];
#pragma unroll
        for (int bj = 0; bj < 2; ++bj)
#pragma unroll
            for (int n = 0; n < 2; ++n) gv[bj][n] = *(const f32x4*)(g + col0 + bj * HALF + 4 * n);
#pragma unroll
        for (int ai = 0; ai < 2; ++ai)
#pragma unroll
            for (int m = 0; m < 4; ++m) { const int row = row0 + ai * HALF + m * 16; float ss = 0.f;
#pragma unroll
                for (int bj = 0; bj < 2; ++bj) { const float* rp = res + (size_t)row * ldr + col0 + bj * HALF;
                    const f32x4 v0 = *(const f32x4*)rp + acc[ai][bj][m][0], v1 = *(const f32x4*)(rp + 4) + acc[ai][bj][m][1];
                    ss += (v0[0] * v0[0] + v0[1] * v0[1]) + (v0[2] * v0[2] + v0[3] * v0[3]) + (v1[0] * v1[0] + v1[1] * v1[1]) + (v1[2] * v1[2] + v1[3] * v1[3]);
                    u32x4 w; w.x = cvt_pk_bf16(v0[0], v0[1]); w.y = cvt_pk_bf16(v0[2], v0[3]); w.z = cvt_pk_bf16(v1[0], v1[1]); w.w = cvt_pk_bf16(v1[2], v1[3]);
                    *(u32x4*)(X1 + (size_t)row * ldx + col0 + bj * HALF) = w;
                    const f32x4 n0 = v0 * gv[bj][0], n1 = v1 * gv[bj][1];
                    w.x = cvt_pk_bf16(n0[0], n0[1]); w.y = cvt_pk_bf16(n0[2], n0[3]); w.z = cvt_pk_bf16(n1[0], n1[1]); w.w = cvt_pk_bf16(n1[2], n1[3]);
                    *(u32x4*)(XN + (size_t)row * ldx + col0 + bj * HALF) = w; }
                ss += __shfl_xor(ss, 16); ss += __shfl_xor(ss, 32);
                if (fq == 0) (void)__hip_atomic_fetch_add(rowssq + row, ss, __ATOMIC_RELAXED, __HIP_MEMORY_SCOPE_AGENT);
                asm volatile("" ::: "memory"); }
    }
};
struct EpiRelu2S {
    static constexpr bool PERM = true, AFTER_DRAIN = false;
    bf16_t* O; int ldc; const float* rowssq; float inv_n, eps;
    __device__ __forceinline__ void operator()(const f32x4 (&acc)[2][2][4][2], const Unit& u, int wr, int wc, int fr, int fq) const {
        const int row0 = u.pm * BM + wr * 64 + fr, col0 = u.pn * BM + wc * 32 + 8 * fq;
#pragma unroll
        for (int ai = 0; ai < 2; ++ai)
#pragma unroll
            for (int m = 0; m < 4; ++m) { const int row = row0 + ai * HALF + m * 16; const float s2 = 1.f / (rowssq[row] * inv_n + eps); bf16_t* rowp = O + (size_t)row * ldc + col0;
#pragma unroll
                for (int bj = 0; bj < 2; ++bj) { f32x4 v0 = acc[ai][bj][m][0], v1 = acc[ai][bj][m][1];
#pragma unroll
                    for (int j = 0; j < 4; ++j) { const float a = fmaxf(v0[j], 0.f), b = fmaxf(v1[j], 0.f); v0[j] = a * a * s2; v1[j] = b * b * s2; }
                    u32x4 w; w.x = cvt_pk_bf16(v0[0], v0[1]); w.y = cvt_pk_bf16(v0[2], v0[3]); w.z = cvt_pk_bf16(v1[0], v1[1]); w.w = cvt_pk_bf16(v1[2], v1[3]);
                    *(u32x4*)(rowp + bj * HALF) = w; } }
    }
};
struct EpiX2 {
    static constexpr bool PERM = true, AFTER_DRAIN = false;
    bf16_t* X; int ldx;
    __device__ __forceinline__ void operator()(const f32x4 (&acc)[2][2][4][2], const Unit& u, int wr, int wc, int fr, int fq) const {
        const int row0 = u.pm * BM + wr * 64 + fr, col0 = u.pn * BM + wc * 32 + 8 * fq;
#pragma unroll
        for (int ai = 0; ai < 2; ++ai)
#pragma unroll
            for (int m = 0; m < 4; ++m) { bf16_t* rowp = X + (size_t)(row0 + ai * HALF + m * 16) * ldx + col0;
                u32x4 x[2];
#pragma unroll
                for (int bj = 0; bj < 2; ++bj) x[bj] = *(const u32x4*)(rowp + bj * HALF);
#pragma unroll
                for (int bj = 0; bj < 2; ++bj) { const f32x4 a0 = acc[ai][bj][m][0], a1 = acc[ai][bj][m][1]; u32x4 w;
                    w.x = cvt_pk_bf16(__uint_as_float(x[bj].x << 16) + a0[0], __uint_as_float(x[bj].x & 0xffff0000u) + a0[1]);
                    w.y = cvt_pk_bf16(__uint_as_float(x[bj].y << 16) + a0[2], __uint_as_float(x[bj].y & 0xffff0000u) + a0[3]);
                    w.z = cvt_pk_bf16(__uint_as_float(x[bj].z << 16) + a1[0], __uint_as_float(x[bj].z & 0xffff0000u) + a1[1]);
                    w.w = cvt_pk_bf16(__uint_as_float(x[bj].w << 16) + a1[2], __uint_as_float(x[bj].w & 0xffff0000u) + a1[3]);
                    *(u32x4*)(rowp + bj * HALF) = w; }
                asm volatile("" ::: "memory"); }
    }
};
struct SplitTailOrder {
    int pm0, kq_len, G, c;
    __device__ __forceinline__ bool next(int i, Unit& u) const {
        const int L = i * G + c; if (L >= 256) return false;
        const int x = L & 7, idx = L >> 3; u.pn = (x & 1) * 8 + (idx & 7); u.pm = pm0 + (idx >> 3); u.k0 = (x >> 1) * kq_len; return true; }
    __device__ __forceinline__ void a_ready(const Unit&) const {}
    __device__ __forceinline__ void done(const Unit&) const {}
};
struct EpiPartF32 {
    static constexpr bool PERM = false, AFTER_DRAIN = false;
    float* P; int ldc, pm0, kq_len; size_t qstride;
    __device__ __forceinline__ void operator()(const f32x4 (&acc)[2][2][4][2], const Unit& u, int wr, int wc, int fr, int fq) const {
        const int row0 = (u.pm - pm0) * BM + wr * 64 + fr, col0 = u.pn * BM + wc * 32 + 4 * fq; float* base = P + (size_t)(u.k0 / kq_len) * qstride;
#pragma unroll
        for (int ai = 0; ai < 2; ++ai)
#pragma unroll
            for (int m = 0; m < 4; ++m) { const size_t off = (size_t)(row0 + ai * HALF + m * 16) * ldc + col0;
#pragma unroll
                for (int bj = 0; bj < 2; ++bj)
#pragma unroll
                    for (int n = 0; n < 2; ++n) *(f32x4*)(base + off + bj * HALF + n * 16) = acc[ai][bj][m][n]; }
    }
};

struct NoFill { static constexpr bool ON = false; static constexpr int NX = 3; int fi, fend; __device__ __forceinline__ void set_wave(int) {} };
template <int DD, int DF>
struct WFill {
    static constexpr bool ON = true;
    static constexpr int NX = 3;
    static constexpr int NI_UP = (DD / 64) * (DF / 64), NI_DN = (DF / 64) * (DD / 64), NI = NI_UP + NI_DN;
    static constexpr int LG_UP = __builtin_ctz(DD / 64), LG_DN = __builtin_ctz(DF / 64);
    static_assert((DD / 64) == (1 << LG_UP) && (DF / 64) == (1 << LG_DN) && LG_UP >= 6 && LG_DN >= 6 && NI_UP % 64 == 0, "WFill: K extents must be 64 * 2^n, n >= 6");
    const float* Wup; const float* Wdn; void* WupT; void* WdnT; int fi, fend;
    int cur, lo, hi;
    const char* sp; char* dp; unsigned nbytes, kbytes;
    typedef unsigned v4u_f __attribute__((ext_vector_type(4)));
    __device__ __forceinline__ void set_wave(int) {}
    __device__ __forceinline__ void locate(int id, int wid) {
        id = __builtin_amdgcn_readfirstlane(id);
        const bool up = id < NI_UP; const int j = up ? id : id - NI_UP, sh = up ? LG_UP : LG_DN, nb = j >> sh, kb = j & ((1 << sh) - 1), N = up ? DF : DD, Kd = up ? DD : DF;
        sp = (const char*)(up ? Wup : Wdn) + ((size_t)(64 * kb) * N + 64 * nb + 8 * wid) * 4;
        dp = (char*)(up ? WupT : WdnT) + ((size_t)(64 * nb + 8 * wid) * Kd + 64 * kb) * 2;
        nbytes = (unsigned)(N * 4); kbytes = (unsigned)(Kd * 2);
    }
    __device__ __forceinline__ void advance(int wid) { int nx = cur + 1; nx = nx == hi ? lo : nx; if ((nx & 63) == 0 || nx == lo) locate(nx, wid); else { sp += (size_t)64 * nbytes; dp += 128; } cur = nx; }
    __device__ __forceinline__ void issue(PG8_LAS unsigned char* buf, int lane) const {
        const int kql = (lane >> 1) & 3, h = lane & 1, jh = lane >> 4, jb = (lane >> 3) & 1;
#pragma unroll
        for (int i = 0; i < 2; ++i) { const int row = 32 * i + 8 * kql + 2 * jh + (jb ^ i);
            __builtin_amdgcn_global_load_lds((const unsigned*)(sp + (unsigned)row * nbytes + (unsigned)h * 16u), (PG8_LAS unsigned*)(buf + i * 1024), 16, 0, 0); }
    }
    __device__ __forceinline__ void read(float (&raw)[8], const PG8_LAS unsigned char* buf, int lane) const {
        const int n = lane >> 3, kq = lane & 7, i = kq >> 2, b0 = i * 1024 + 32 * (kq & 3) + 16 * (n >> 2) + 4 * (n & 3);
        const PG8_LAS unsigned char* be = buf + b0 + 128 * i; const PG8_LAS unsigned char* bo = buf + b0 + 128 * (1 - i);
#pragma unroll
        for (int j = 0; j < 8; ++j) raw[j] = *(const PG8_LAS float*)(((j & 1) ? bo : be) + 256 * (j >> 1));
    }
    __device__ __forceinline__ void store(const float (&raw)[8], int lane) const {
        v4u_f w; w.x = cvt_pk_bf16(raw[0], raw[1]); w.y = cvt_pk_bf16(raw[2], raw[3]); w.z = cvt_pk_bf16(raw[4], raw[5]); w.w = cvt_pk_bf16(raw[6], raw[7]);
        *(__attribute__((address_space(1))) v4u_f*)(dp + (unsigned)(lane >> 3) * kbytes + (unsigned)(lane & 7) * 16u) = w;
    }
};
template <class Epi, class Sched, bool ALIGN_EPI = false, bool SP2 = false, class Fill = NoFill>
__device__ __forceinline__ void gemm_phase(PG8_LAS unsigned char* lds, const Gemm g, const Sched& S, const Epi& E, Fill FL = Fill()) {
    static_assert(!Fill::ON || SP2, "the filler is written for the SP2 loop"); static_assert(Fill::NX == 3, "the filler waits below are written as vmcnt(8 + 3)");
    PG8_LAS unsigned char* fbuf = lds + STAGE_BYTES + (__builtin_amdgcn_readfirstlane(threadIdx.x >> 6)) * 2048;
    const int tid = threadIdx.x, wid = __builtin_amdgcn_readfirstlane(tid >> 6), lane = tid & 63, wr = wid >> 2, wc = wid & 3, fr = lane & 15, fq = lane >> 4;
    const int K = g.ld, nt = g.K / BK;
    unsigned voffA[2], voffB[2];
#pragma unroll
    for (int i = 0; i < 2; ++i) { int R, C; stage_rc(tid * 16 + i * 8192, R, C); const int Rb = Epi::PERM ? ((R & ~31) + perm32(R & 31)) : R;
        voffA[i] = (unsigned)(R * K + C) * 2u; voffB[i] = (unsigned)(Rb * K + C) * 2u; }
    const size_t kstep = (size_t)(BK * 2);
    const size_t hstep = (size_t)HALF * K * 2;
    const size_t tstep = 2 * hstep;
    const unsigned ldsw = (unsigned)wid * 1024u;
    const int aoff = lds_byte(wr * 64 + fr, fq * 8), boff = lds_byte(wc * 32 + fr, fq * 8);
#define PG8_SA(b, h) (((b) * 2 + (h)) * HTB)
#define PG8_SB(b, h) ((4 + (b) * 2 + (h)) * HTB)
#define PG8_STAGE(bufoff, gbase, voff) do { _Pragma("unroll") for (int _i = 0; _i < 2; ++_i) \
        __builtin_amdgcn_global_load_lds((const unsigned*)((const char*)(gbase) + (voff)[_i]), (PG8_LAS unsigned*)(lds + (bufoff) + ldsw + _i * 8192), 16, 0, 0); } while (0)
#define PG8_LDA(dst, b, h) do { _Pragma("unroll") for (int m = 0; m < 4; ++m) _Pragma("unroll") for (int k = 0; k < 2; ++k) dst[m][k] = *(const PG8_LAS bf16x8*)(lds + PG8_SA(b, h) + aoff + m * 2048 + k * 1024); } while (0)
#define PG8_LDB(dst, b, h) do { _Pragma("unroll") for (int n = 0; n < 2; ++n) _Pragma("unroll") for (int k = 0; k < 2; ++k) dst[n][k] = *(const PG8_LAS bf16x8*)(lds + PG8_SB(b, h) + boff + n * 2048 + k * 1024); } while (0)
#define PG8_MMA(ai, bj, At, Bt) do { __builtin_amdgcn_s_setprio(1); _Pragma("unroll") for (int m = 0; m < 4; ++m) _Pragma("unroll") for (int n = 0; n < 2; ++n) _Pragma("unroll") for (int k = 0; k < 2; ++k) \
        acc[ai][bj][m][n] = __builtin_amdgcn_mfma_f32_16x16x32_bf16(Bt[n][k], At[m][k], acc[ai][bj][m][n], 0, 0, 0); __builtin_amdgcn_s_setprio(0); } while (0)
#define PG8_WAIT_V(n) asm volatile("s_waitcnt vmcnt(" #n ")" ::: "memory")
#define PG8_WAIT_L(n) asm volatile("s_waitcnt lgkmcnt(" #n ")" ::: "memory")
#define PG8_BAR __builtin_amdgcn_s_barrier()
#define PG8_SCHED __builtin_amdgcn_sched_barrier(0)
    Unit cur, nxt; int ui = 0;
    if constexpr (Fill::ON) { if (FL.fi < FL.fend) { FL.locate(FL.cur, wid); FL.issue(fbuf, lane); } }
    if (S.next(0, cur)) {
    f32x4 acc[2][2][4][2];
#pragma unroll
    for (int a = 0; a < 2; ++a)
#pragma unroll
        for (int b = 0; b < 2; ++b)
#pragma unroll
            for (int m = 0; m < 4; ++m)
#pragma unroll
                for (int n = 0; n < 2; ++n) acc[a][b][m][n] = (f32x4){0.f, 0.f, 0.f, 0.f};
    bf16x8 At[4][2], B0[2][2], B1[2][2];
    const char* cA = (const char*)g.A + (size_t)cur.pm * tstep + (size_t)cur.k0 * 2; const char* cB = (const char*)g.Bt + (size_t)cur.pn * tstep + (size_t)cur.k0 * 2;
    S.a_ready(cur);
    if constexpr (SP2) {
        PG8_STAGE(PG8_SB(0, 0), cB, voffB); PG8_STAGE(PG8_SB(0, 1), cB + hstep, voffB); PG8_STAGE(PG8_SA(0, 0), cA, voffA); PG8_STAGE(PG8_SA(0, 1), cA + hstep, voffA);
        if (wr == 1) PG8_BAR;
        PG8_WAIT_V(2); PG8_BAR;
        PG8_STAGE(PG8_SB(1, 0), cB + kstep, voffB); PG8_STAGE(PG8_SA(1, 0), cA + kstep, voffA); PG8_STAGE(PG8_SB(1, 1), cB + hstep + kstep, voffB);
        PG8_WAIT_V(6); PG8_BAR;
    } else {
        PG8_STAGE(PG8_SB(0, 0), cB, voffB); PG8_STAGE(PG8_SA(0, 0), cA, voffA); PG8_STAGE(PG8_SB(0, 1), cB + hstep, voffB); PG8_STAGE(PG8_SA(0, 1), cA + hstep, voffA);
        if (wr == 1) PG8_BAR;
        PG8_WAIT_V(4); PG8_BAR;
        PG8_STAGE(PG8_SB(1, 0), cB + kstep, voffB); PG8_STAGE(PG8_SA(1, 0), cA + kstep, voffA); PG8_STAGE(PG8_SB(1, 1), cB + hstep + kstep, voffB);
        PG8_WAIT_V(6); PG8_BAR;
    }
    for (;;) {
        const bool has_next = S.next(ui + 1, nxt);
        const char* nA = has_next ? (const char*)g.A + (size_t)nxt.pm * tstep + (size_t)nxt.k0 * 2 : cA; const char* nB = has_next ? (const char*)g.Bt + (size_t)nxt.pn * tstep + (size_t)nxt.k0 * 2 : cB;
        for (int t = 0; t < nt; t += 2) {
            const bool last = (t == nt - 2);
            const char* a1 = cA + (size_t)(t + 1) * kstep;
            const char* a2 = last ? nA : cA + (size_t)(t + 2) * kstep; const char* b2 = last ? nB : cB + (size_t)(t + 2) * kstep;
            const char* a3 = a2 + kstep; const char* b3 = b2 + kstep;
            if (last && has_next) S.a_ready(nxt);
            if constexpr (SP2) {
            bool fact = false; float fraw[8];
            if constexpr (Fill::ON) { fact = FL.fi < FL.fend; if (fact) { FL.read(fraw, fbuf, lane); PG8_SCHED; } }
            PG8_LDB(B0, 0, 0); PG8_LDB(B1, 0, 1); PG8_SCHED; PG8_LDA(At, 0, 0); PG8_STAGE(PG8_SA(1, 1), a1 + hstep, voffA);
            if constexpr (Fill::ON) { if (fact) { PG8_SCHED; FL.store(fraw, lane); asm volatile("" ::: "memory");
                    if (FL.fi + 1 < FL.fend) FL.advance(wid); FL.issue(fbuf, lane); FL.fi += 1; PG8_SCHED; } }
            if (fact) PG8_WAIT_V(11); else PG8_WAIT_V(8);
            PG8_WAIT_L(0); PG8_BAR; PG8_MMA(0, 0, At, B0); PG8_MMA(0, 1, At, B1); PG8_BAR; PG8_SCHED;
            PG8_LDA(At, 0, 1); PG8_STAGE(PG8_SB(0, 0), b2, voffB); PG8_STAGE(PG8_SB(0, 1), b2 + hstep, voffB); PG8_STAGE(PG8_SA(0, 0), a2, voffA);
            if (fact) PG8_WAIT_V(11); else PG8_WAIT_V(8);
            PG8_WAIT_L(0); PG8_BAR; PG8_MMA(1, 0, At, B0); PG8_MMA(1, 1, At, B1); PG8_BAR; PG8_SCHED;
            PG8_LDB(B0, 1, 0); PG8_LDB(B1, 1, 1); PG8_SCHED; PG8_LDA(At, 1, 0); PG8_STAGE(PG8_SA(0, 1), a2 + hstep, voffA);
            if (fact) PG8_WAIT_V(11); else PG8_WAIT_V(8);
            PG8_WAIT_L(0); PG8_BAR; PG8_MMA(0, 0, At, B0); PG8_MMA(0, 1, At, B1); PG8_BAR; PG8_SCHED;
            PG8_LDA(At, 1, 1); PG8_STAGE(PG8_SB(1, 0), b3, voffB); PG8_STAGE(PG8_SB(1, 1), b3 + hstep, voffB); PG8_STAGE(PG8_SA(1, 0), a3, voffA);
            PG8_WAIT_V(8); PG8_WAIT_L(0); PG8_BAR; PG8_MMA(1, 0, At, B0); PG8_MMA(1, 1, At, B1); PG8_BAR; PG8_SCHED;
            } else {
            PG8_LDB(B0, 0, 0); PG8_SCHED; PG8_LDA(At, 0, 0); PG8_STAGE(PG8_SA(1, 1), a1 + hstep, voffA);
            PG8_WAIT_L(8); PG8_BAR; PG8_WAIT_L(0); PG8_MMA(0, 0, At, B0); PG8_BAR; PG8_SCHED;
            PG8_LDB(B1, 0, 1); PG8_STAGE(PG8_SB(0, 0), b2, voffB);
            PG8_BAR; PG8_WAIT_L(0); PG8_MMA(0, 1, At, B1); PG8_BAR;
            PG8_LDA(At, 0, 1); PG8_STAGE(PG8_SA(0, 0), a2, voffA);
            PG8_BAR; PG8_WAIT_L(0); PG8_MMA(1, 0, At, B0); PG8_BAR; PG8_SCHED;
            PG8_STAGE(PG8_SB(0, 1), b2 + hstep, voffB);
            PG8_WAIT_V(6); PG8_BAR; PG8_MMA(1, 1, At, B1); PG8_BAR;
            PG8_LDB(B0, 1, 0); PG8_SCHED; PG8_LDA(At, 1, 0); PG8_STAGE(PG8_SA(0, 1), a2 + hstep, voffA);
            PG8_WAIT_L(8); PG8_BAR; PG8_WAIT_L(0); PG8_MMA(0, 0, At, B0); PG8_BAR; PG8_SCHED;
            PG8_LDB(B1, 1, 1); PG8_STAGE(PG8_SB(1, 0), b3, voffB);
            PG8_BAR; PG8_WAIT_L(0); PG8_MMA(0, 1, At, B1); PG8_BAR;
            PG8_LDA(At, 1, 1); PG8_STAGE(PG8_SA(1, 0), a3, voffA);
            PG8_BAR; PG8_WAIT_L(0); PG8_MMA(1, 0, At, B0); PG8_BAR; PG8_SCHED;
            PG8_STAGE(PG8_SB(1, 1), b3 + hstep, voffB);
            PG8_WAIT_V(6); PG8_BAR; PG8_MMA(1, 1, At, B1); PG8_BAR;
            }
        }
        if constexpr (ALIGN_EPI) { if (wr == 0) PG8_BAR; }
        if constexpr (!Epi::AFTER_DRAIN) { E(acc, cur, wr, wc, fr, fq); S.done(cur); }
        if (!has_next) break;
#pragma unroll
        for (int a = 0; a < 2; ++a)
#pragma unroll
            for (int b = 0; b < 2; ++b)
#pragma unroll
                for (int m = 0; m < 4; ++m)
#pragma unroll
                    for (int n = 0; n < 2; ++n) acc[a][b][m][n] = (f32x4){0.f, 0.f, 0.f, 0.f};
        cur = nxt; cA = nA; cB = nB; ++ui;
        if constexpr (ALIGN_EPI) { if (wr == 1) PG8_BAR; }
    }
    PG8_WAIT_V(0);
    if constexpr (!ALIGN_EPI) { if (wr == 0) PG8_BAR; }
    PG8_BAR;
    if constexpr (Epi::AFTER_DRAIN) { E.fused(acc, cur, wr, wc, fr, fq, lds, wid, lane); S.done(cur); }
    }
    if constexpr (Fill::ON) {
        while (FL.fi < FL.fend) { float fraw[8]; PG8_WAIT_V(0); FL.read(fraw, fbuf, lane); FL.store(fraw, lane); PG8_WAIT_L(0); asm volatile("" ::: "memory");
            if (FL.fi + 1 < FL.fend) { FL.advance(wid); FL.issue(fbuf, lane); } FL.fi += 1; }
        PG8_WAIT_V(0);
    }
#undef PG8_SA
#undef PG8_SB
#undef PG8_STAGE
#undef PG8_LDA
#undef PG8_LDB
#undef PG8_MMA
#undef PG8_WAIT_V
#undef PG8_WAIT_L
#undef PG8_BAR
#undef PG8_SCHED
}
}

constexpr int NWAVES = 8;
#ifndef MK_N_LAUNCHES
#define MK_N_LAUNCHES 1
#endif
#ifndef PROBE_REPEAT
#define PROBE_REPEAT -1
#endif
constexpr int N_LAUNCHES = MK_N_LAUNCHES;
constexpr int N_PHASES = 9;
static_assert(N_LAUNCHES == 1 || N_LAUNCHES == N_PHASES, "MK_N_LAUNCHES is 1 or 9");
#ifndef MIX_SLOW_GATHER
#define MIX_SLOW_GATHER 0
#endif

constexpr int D = 4096, MP = 8192, MS = 1024, M = MP + MS, NPROJ = 12288, NPROJ_PAD = 12544, IN_COLS = 12296, FF = 16384;
constexpr int SEQ = 2048, NB = 4, DECB = 128, DECT = 8, PAST = 16384;
constexpr int HM = 4, DKM = 256, DVM = 512, HR = 8, DKR = 128, DVR = 256;
constexpr float RMS_EPS = 1e-6f, SOFTCAP = 15.f;
constexpr int PC_QM = 0, PC_KM = 1024, PC_VM = 2048, PC_OM = 4096, PC_QR = 6144, PC_KR = 7168, PC_VR = 8192, PC_GR = 10240;
constexpr size_t O_Y = 0, O_PC = 37748736, O_PN = 39845888, O_PM = 39849984, O_PS = 39850000, O_SC = 40898576, O_SN = 108007440, O_SM = 108138512, O_SS = 108139024, O_END = 141693456;
constexpr size_t MiB = 1u << 20;
constexpr size_t WS_CTL = 0, CTL_ZERO_BYTES = 1 * MiB;
constexpr size_t WS_WIN = 2 * MiB, WS_WOUT = 100 * MiB, WS_WUP = 132 * MiB, WS_WDN = 260 * MiB;
constexpr size_t WS_XN = 388 * MiB;
constexpr size_t WS_PROJ = 460 * MiB;
constexpr size_t WS_GATES = 676 * MiB;
constexpr size_t WS_SSQ = 677 * MiB;
constexpr size_t WS_ROPE = 682 * MiB;
constexpr size_t WS_HRAW = 684 * MiB;
constexpr size_t WS_X1B = WS_HRAW;
constexpr size_t WS_CAT = 756 * MiB;
constexpr size_t WS_U = 828 * MiB;
constexpr size_t WS_PART = 1116 * MiB;
constexpr size_t WS_END = 1180 * MiB;
static_assert(WS_WIN + (size_t)NPROJ_PAD * D * 2 <= WS_WOUT && WS_WOUT + (size_t)D * D * 2 <= WS_WUP && WS_WUP + (size_t)FF * D * 2 <= WS_WDN && WS_WDN + (size_t)FF * D * 2 <= WS_XN, "ws map 1");
static_assert(WS_XN + (size_t)M * D * 2 <= WS_PROJ && WS_PROJ + (size_t)M * NPROJ * 2 <= WS_GATES && WS_GATES + (size_t)M * 8 * 4 <= WS_SSQ && WS_SSQ + (size_t)M * 128 * 4 <= WS_ROPE, "ws map 2");
static_assert(WS_ROPE + (size_t)2056 * 64 * 8 <= WS_HRAW && WS_HRAW + (size_t)M * D * 2 <= WS_CAT && WS_CAT + (size_t)M * D * 2 <= WS_U && WS_U + (size_t)M * FF * 2 <= WS_PART && WS_PART + (size_t)4 * MS * D * 4 <= WS_END, "ws map 3");
constexpr int CW_TMO = 0, CW_CODE = 1;
constexpr int CW_BAR = 4096;
constexpr int CW_ROWSSQ = 16384;
constexpr int CW_QUEUE = 8192;
constexpr int LDS_BYTES = 163840;
constexpr int LDSCTL_OFF = 162816, MISC_OFF = LDSCTL_OFF + 320;
static_assert(MISC_OFF + 128 <= LDS_BYTES, "LDS map");

#define GAS __attribute__((address_space(1)))
#define LAS __attribute__((address_space(3)))
typedef unsigned short bf16;
typedef unsigned v4u __attribute__((ext_vector_type(4)));
typedef unsigned v2u __attribute__((ext_vector_type(2)));
typedef float f32x4 __attribute__((ext_vector_type(4)));
typedef float f32x2 __attribute__((ext_vector_type(2)));
typedef short bf16x8 __attribute__((ext_vector_type(8)));
typedef short s16x4 __attribute__((ext_vector_type(4)));
typedef GAS unsigned gu32;
#define RLX_AGENT __ATOMIC_RELAXED, __HIP_MEMORY_SCOPE_AGENT
#define LDS_WAIT() asm volatile("s_waitcnt lgkmcnt(0)" ::: "memory")
#define VM_WAIT() asm volatile("s_waitcnt vmcnt(0)" ::: "memory")
typedef float f32x2_t __attribute__((ext_vector_type(2))); typedef __bf16 bf16x2_t __attribute__((ext_vector_type(2)));
__device__ __forceinline__ unsigned pk2(float lo, float hi) { const f32x2_t v = {lo, hi}; const bf16x2_t b = __builtin_convertvector(v, bf16x2_t); return __builtin_bit_cast(unsigned, b); }
__device__ __forceinline__ float bf_lo(unsigned w) { return __uint_as_float(w << 16); }
__device__ __forceinline__ float bf_hi(unsigned w) { return __uint_as_float(w & 0xffff0000u); }

#define XB_TMO      128
#define XB_XCNT(j)  (256  + 64 * (j))
#define XB_XSUB(j)  (1280 + 64 * (j))
#define XB_XGEN(j)  (2304 + 64 * (j))
#define XB_TOP      3328
#define XB_TOPGEN   3392
#define XCD_BAR_WORDS 3456
#define XB_SPIN_CAP (1u << 18)

__device__ __forceinline__ unsigned xb_ld(unsigned* p)              { return __hip_atomic_load(p, __ATOMIC_RELAXED, __HIP_MEMORY_SCOPE_AGENT); }
__device__ __forceinline__ unsigned xb_add(unsigned* p, unsigned v) { return __hip_atomic_fetch_add(p, v, __ATOMIC_RELAXED, __HIP_MEMORY_SCOPE_AGENT); }
__device__ __forceinline__ unsigned xb_xcc_id() { return (unsigned)__builtin_amdgcn_s_getreg((3 << 11) | 20) & 0xFu; }
#define XB_SPIN(cond, bar) do { unsigned _sp = 0; while (cond) { __builtin_amdgcn_s_sleep(1); \
    if ((++_sp & 255u) == 0u) { if (xb_ld(&(bar)[XB_TMO])) break; if (_sp > XB_SPIN_CAP) { atomicAdd(&(bar)[XB_TMO], 1u); break; } } } } while (0)

struct XcdBarrier {
    unsigned* bar; unsigned x;
    volatile LAS unsigned* st;
};

__device__ __forceinline__ XcdBarrier xcd_barrier_post(unsigned* bar, volatile LAS unsigned* st) {
    XcdBarrier b; b.bar = bar; b.x = xb_xcc_id(); b.st = st;
    if (threadIdx.x == 0) (void)xb_add(&bar[XB_XCNT(b.x)], 1u);
    return b;
}
__device__ __forceinline__ void xcd_barrier_complete(unsigned* bar, unsigned x, unsigned& nloc, unsigned& nx) {
    const unsigned G = gridDim.x * gridDim.y * gridDim.z;
    unsigned sum, cnt, mine, sp = 0u;
    for (;;) {
        sum = 0u; cnt = 0u; mine = 0u;
#pragma unroll
        for (unsigned j = 0; j < 16; ++j) { const unsigned c = xb_ld(&bar[XB_XCNT(j)]); sum += c; cnt += (c > 0u) ? 1u : 0u; mine = (j == x) ? c : mine; }
        if (sum == G) break;
        __builtin_amdgcn_s_sleep(1);
        if ((++sp & 255u) == 0u) { if (xb_ld(&bar[XB_TMO])) break; if (sp > XB_SPIN_CAP) { atomicAdd(&bar[XB_TMO], 1u); break; } }
    }
    nloc = mine > 0u ? mine : 1u; nx = cnt > 0u ? cnt : 1u;
}

__device__ __forceinline__ void xcd_barrier(const XcdBarrier& b) {
    asm volatile("s_waitcnt vmcnt(0)" ::: "memory");
    __syncthreads();
    if (threadIdx.x == 0) {
        unsigned* bar = b.bar;
        __builtin_amdgcn_s_waitcnt(0);
        unsigned nloc = b.st[0], nx = b.st[1];
        if (nloc == 0u) { xcd_barrier_complete(bar, b.x, nloc, nx); b.st[0] = nloc; b.st[1] = nx; }
        const unsigned old = xb_add(&bar[XB_XSUB(b.x)], 1u);
        const unsigned gen = old / nloc;
        if (old + 1u == (gen + 1u) * nloc) {
            __builtin_amdgcn_fence(__ATOMIC_RELEASE, "agent");
            asm volatile("s_waitcnt vmcnt(0)" ::: "memory");
            const unsigned og = xb_add(&bar[XB_TOP], 1u);
            const unsigned tg = og / nx;
            if (og + 1u == (tg + 1u) * nx) xb_add(&bar[XB_TOPGEN], 1u);
            else XB_SPIN(xb_ld(&bar[XB_TOPGEN]) == tg, bar);
            __builtin_amdgcn_fence(__ATOMIC_ACQUIRE, "agent");
            xb_add(&bar[XB_XGEN(b.x)], 1u);
            asm volatile("s_waitcnt vmcnt(0)" ::: "memory");
        } else {
            XB_SPIN(xb_ld(&bar[XB_XGEN(b.x)]) == gen, bar);
            __builtin_amdgcn_fence(__ATOMIC_ACQUIRE, "agent");
            asm volatile("s_waitcnt vmcnt(0)" ::: "memory");
        }
    }
    __syncthreads();
}

struct Frame {
    LAS unsigned char* lds;
    volatile LAS unsigned* MISC;
    gu32* ctl;
    int tid, lane, wave;
    int vcu, G;
    const float* in[17]; float* out; unsigned char* ws;
};
__device__ __forceinline__ float wave_sum(float v) {
#pragma unroll
    for (int o = 1; o < 64; o <<= 1) v += __shfl_xor(v, o);
    return v;
}
__device__ __forceinline__ const float* x_row(const Frame& F, int m) { return m < MP ? F.in[0] + (size_t)m * D : F.in[1] + (size_t)(m - MP) * D; }

__device__ __forceinline__ void p0_transpose_item(const float* W, int ldw, int K, int k0, int src_col0, bf16* WT, int dst_row0, LAS float* scr, int lane) {
#pragma unroll 8
    for (int i = 0; i < 32; ++i) { const int kk = 2 * i + (lane >> 5); scr[kk * 33 + (lane & 31)] = W[(size_t)(k0 + kk) * ldw + src_col0 + (lane & 31)]; }
    LDS_WAIT(); asm volatile("" ::: "memory");
    const int c = lane & 7;
#pragma unroll
    for (int j = 0; j < 4; ++j) { const int n = (lane >> 3) + 8 * j; const LAS float* s = scr + (8 * c) * 33 + n;
        v4u o; o.x = pk2(s[0 * 33], s[1 * 33]); o.y = pk2(s[2 * 33], s[3 * 33]); o.z = pk2(s[4 * 33], s[5 * 33]); o.w = pk2(s[6 * 33], s[7 * 33]);
        *(GAS v4u*)(WT + (size_t)(dst_row0 + n) * K + k0 + 8 * c) = o; }
    LDS_WAIT(); asm volatile("" ::: "memory");
}
template <bool OUT_BF16>
__device__ __forceinline__ void rms_row(const float* xrow, const float* g, void* orow, int lane) {
    const GAS f32x4* xr = (const GAS f32x4*)xrow + lane; const GAS f32x4* gr = (const GAS f32x4*)g + lane;
    f32x4 v[16]; float s = 0.f;
#pragma unroll
    for (int j = 0; j < 16; ++j) { v[j] = xr[64 * j]; s += (v[j].x * v[j].x + v[j].y * v[j].y) + (v[j].z * v[j].z + v[j].w * v[j].w); }
    const float rstd = 1.f / sqrtf(wave_sum(s) * (1.f / D) + RMS_EPS);
#pragma unroll
    for (int j = 0; j < 16; ++j) { const f32x4 o = v[j] * rstd * gr[64 * j];
        if (OUT_BF16) { v2u w; w.x = pk2(o.x, o.y); w.y = pk2(o.z, o.w); ((GAS v2u*)orow)[lane + 64 * j] = w; }
        else ((GAS f32x4*)orow)[lane + 64 * j] = o; }
}
template <bool OUT_BF16>
__device__ __forceinline__ void rms_row_sum(const float* base, const float* part, size_t qstride, float* xsum, const float* g, void* orow, int lane) {
    const GAS f32x4* xr = (const GAS f32x4*)base + lane; const GAS f32x4* pr = (const GAS f32x4*)part + lane; const GAS f32x4* gr = (const GAS f32x4*)g + lane; const size_t q4 = qstride / 4;
    f32x4 v[16]; float s = 0.f;
#pragma unroll
    for (int j = 0; j < 16; ++j) { v[j] = xr[64 * j] + ((pr[64 * j] + pr[q4 + 64 * j]) + (pr[2 * q4 + 64 * j] + pr[3 * q4 + 64 * j])); s += (v[j].x * v[j].x + v[j].y * v[j].y) + (v[j].z * v[j].z + v[j].w * v[j].w); }
    if (xsum) {
#pragma unroll
        for (int j = 0; j < 16; ++j) ((GAS f32x4*)xsum)[lane + 64 * j] = v[j]; }
    const float rstd = 1.f / sqrtf(wave_sum(s) * (1.f / D) + RMS_EPS);
#pragma unroll
    for (int j = 0; j < 16; ++j) { const f32x4 o = v[j] * rstd * gr[64 * j];
        if (OUT_BF16) { v2u w; w.x = pk2(o.x, o.y); w.y = pk2(o.z, o.w); ((GAS v2u*)orow)[lane + 64 * j] = w; }
        else ((GAS f32x4*)orow)[lane + 64 * j] = o; }
}
__device__ __forceinline__ void x1_sample_row(const float* x, const float* part, size_t qstride, const float* g, bf16* x1b, bf16* xn, float* ssq_out, int lane) {
    float s = 0.f;
#pragma unroll
    for (int j = 0; j < 8; ++j) { const int c = lane + 64 * j; f32x4 v0 = *(const GAS f32x4*)(x + 8 * c), v1 = *(const GAS f32x4*)(x + 8 * c + 4);
#pragma unroll
        for (int q = 0; q < 4; ++q) { v0 += *(const GAS f32x4*)(part + q * qstride + 8 * c); v1 += *(const GAS f32x4*)(part + q * qstride + 8 * c + 4); }
        s += (v0.x * v0.x + v0.y * v0.y) + (v0.z * v0.z + v0.w * v0.w) + (v1.x * v1.x + v1.y * v1.y) + (v1.z * v1.z + v1.w * v1.w);
        v4u w; w.x = pk2(v0.x, v0.y); w.y = pk2(v0.z, v0.w); w.z = pk2(v1.x, v1.y); w.w = pk2(v1.z, v1.w); ((GAS v4u*)x1b)[c] = w;
        const f32x4 g0 = *(const GAS f32x4*)(g + 8 * c), g1 = *(const GAS f32x4*)(g + 8 * c + 4); v0 = v0 * g0; v1 = v1 * g1;
        w.x = pk2(v0.x, v0.y); w.y = pk2(v0.z, v0.w); w.z = pk2(v1.x, v1.y); w.w = pk2(v1.z, v1.w); ((GAS v4u*)xn)[c] = w; }
    s = wave_sum(s);
    if (lane == 0) *ssq_out = s;
}
template <bool PART>
__device__ __forceinline__ void final_row(const bf16* xb, const float* part, size_t qstride, const float* g, float* y, int lane) {
    f32x4 v[8][2]; float s = 0.f;
#pragma unroll
    for (int j = 0; j < 8; ++j) { const int c = lane + 64 * j; const v4u w = ((const GAS v4u*)xb)[c];
        v[j][0] = (f32x4){bf_lo(w.x), bf_hi(w.x), bf_lo(w.y), bf_hi(w.y)}; v[j][1] = (f32x4){bf_lo(w.z), bf_hi(w.z), bf_lo(w.w), bf_hi(w.w)};
        if (PART) {
#pragma unroll
            for (int q = 0; q < 4; ++q) { v[j][0] += *(const GAS f32x4*)(part + q * qstride + 8 * c); v[j][1] += *(const GAS f32x4*)(part + q * qstride + 8 * c + 4); } }
        s += (v[j][0].x * v[j][0].x + v[j][0].y * v[j][0].y) + (v[j][0].z * v[j][0].z + v[j][0].w * v[j][0].w) + (v[j][1].x * v[j][1].x + v[j][1].y * v[j][1].y) + (v[j][1].z * v[j][1].z + v[j][1].w * v[j][1].w); }
    const float rstd = 1.f / sqrtf(wave_sum(s) * (1.f / D) + RMS_EPS);
#pragma unroll
    for (int j = 0; j < 8; ++j) { const int c = lane + 64 * j;
        *(GAS f32x4*)(y + 8 * c) = v[j][0] * rstd * *(const GAS f32x4*)(g + 8 * c); *(GAS f32x4*)(y + 8 * c + 4) = v[j][1] * rstd * *(const GAS f32x4*)(g + 8 * c + 4); }
}
__device__ __forceinline__ void frow_load(v2u (&xw)[16], const bf16* xb, int lane) {
#pragma unroll
    for (int j = 0; j < 16; ++j) xw[j] = ((const GAS v2u*)xb)[lane + 64 * j];
}
template <bool PART>
__device__ __forceinline__ void frow_finish(const v2u (&xw)[16], const float* part, size_t qstride, const float* g, float* y, int lane) {
    f32x4 v[16]; float s = 0.f;
#pragma unroll
    for (int j = 0; j < 16; ++j) { v[j] = (f32x4){bf_lo(xw[j].x), bf_hi(xw[j].x), bf_lo(xw[j].y), bf_hi(xw[j].y)};
        if (PART) { const GAS f32x4* p = (const GAS f32x4*)part + lane + 64 * j; const size_t q4 = qstride / 4; v[j] += (p[0] + p[q4]) + (p[2 * q4] + p[3 * q4]); if ((j & 3) == 3) asm volatile("" ::: "memory"); }
        s += (v[j].x * v[j].x + v[j].y * v[j].y) + (v[j].z * v[j].z + v[j].w * v[j].w); }
    const float rstd = 1.f / sqrtf(wave_sum(s) * (1.f / D) + RMS_EPS);
#pragma unroll
    for (int j = 0; j < 16; ++j) { ((GAS f32x4*)y)[lane + 64 * j] = v[j] * rstd * ((const GAS f32x4*)g)[lane + 64 * j]; if ((j & 3) == 3) asm volatile("" ::: "memory"); }
}
__device__ __forceinline__ void sincos_d(float a, float& c, float& s) {
    const double x = (double)a; const double n = rint(x * 0.63661977236758134308);
    double r = fma(-n, 1.57079632679489655800e+00, x); r = fma(-n, 6.12323399573676603587e-17, r);
    const double r2 = r * r;
    double sp = -7.6471637318198164759e-13; sp = fma(sp, r2, 1.6059043836821614599e-10); sp = fma(sp, r2, -2.5052108385441718775e-08); sp = fma(sp, r2, 2.7557319223985890653e-06);
    sp = fma(sp, r2, -1.9841269841269841270e-04); sp = fma(sp, r2, 8.3333333333333333333e-03); sp = fma(sp, r2, -1.6666666666666666667e-01); const double sn = fma(sp * r2, r, r);
    double cp = 4.7794773323873852974e-14; cp = fma(cp, r2, -1.1470745597729724714e-11); cp = fma(cp, r2, 2.0876756987868098979e-09); cp = fma(cp, r2, -2.7557319223985890653e-07);
    cp = fma(cp, r2, 2.4801587301587301587e-05); cp = fma(cp, r2, -1.3888888888888888889e-03); cp = fma(cp, r2, 4.1666666666666666667e-02); cp = fma(cp, r2, -0.5); const double cs = fma(cp, r2, 1.0);
    const int q = (int)n & 3;
    const double ss = (q & 1) ? cs : sn, cc = (q & 1) ? sn : cs;
    s = (float)((q & 2) ? -ss : ss); c = (float)(((q + 1) & 2) ? -cc : cc);
}
__device__ __forceinline__ void p0_prologue(Frame& F) {
    LAS float* scr = (LAS float*)(F.lds + F.wave * 16384);
    const int gw = F.vcu * NWAVES + F.wave, NGW = F.G * NWAVES;
    const float* Win = F.in[6]; const float* Wout = F.in[11]; const float* Wup = F.in[14]; const float* Wdn = F.in[15];
    bf16* WinT = (bf16*)(F.ws + WS_WIN); bf16* WoutT = (bf16*)(F.ws + WS_WOUT); bf16* WupT = (bf16*)(F.ws + WS_WUP); bf16* WdnT = (bf16*)(F.ws + WS_WDN);
    constexpr int I_IN = (D / 64) * (NPROJ / 32), I_OUT = (D / 64) * (D / 32), I_UP = (D / 64) * (FF / 32), I_DN = (FF / 64) * (D / 32);
    constexpr int NITEMS = I_IN + I_OUT;
    for (int it = gw; it < NITEMS; it += NGW) {
        int r = NITEMS - 1 - it;
        if (r < I_IN) { const int nblk = NPROJ / 32, kb = r / nblk, nb = r % nblk, n0 = 32 * nb; p0_transpose_item(Win, IN_COLS, D, 64 * kb, n0 < 6144 ? n0 : n0 + 8, WinT, n0, scr, F.lane); continue; } r -= I_IN;
        { const int nblk = D / 32, kb = r / nblk, nb = r % nblk; p0_transpose_item(Wout, D, D, 64 * kb, 32 * nb, WoutT, 32 * nb, scr, F.lane); }
    }
    { const int gt = (F.vcu * NWAVES + F.wave) * 64 + F.lane, NGT = F.G * NWAVES * 64;
      for (int i = gt; i < 8 * D; i += NGT) { const int n = i / D, k = i % D; WinT[(size_t)(NPROJ + n) * D + k] = (bf16)(pk2(Win[(size_t)k * IN_COLS + 6144 + n], 0.f) & 0xffffu); }
      GAS v4u* z = (GAS v4u*)(WinT + (size_t)(NPROJ + 8) * D); const int nz = (NPROJ_PAD - NPROJ - 8) * D / 8;
      for (int i = gt; i < nz; i += NGT) z[i] = (v4u){0u, 0u, 0u, 0u};
      GAS f32x2* rope = (GAS f32x2*)(F.ws + WS_ROPE);
      for (int i = gt; i < 2056 * 64; i += NGT) { const int pi = i >> 6, j = i & 63; const float pos = (float)(pi < 2048 ? pi : PAST + pi - 2048);
          double fd = 1.0; if (j & 1) fd *= 0.8659643233600653; if (j & 2) fd *= 0.7498942093324559; if (j & 4) fd *= 0.5623413251903491; if (j & 8) fd *= 0.31622776601683794; if (j & 16) fd *= 0.1; if (j & 32) fd *= 0.01;
          const float freq = (float)fd; const float ang = pos * freq; float c, s; sincos_d(ang, c, s); rope[i] = (f32x2){c, s}; }
    }
    bf16* XN = (bf16*)(F.ws + WS_XN);
    for (int m = gw; m < M; m += NGW) rms_row<true>(x_row(F, m), F.in[12], XN + (size_t)m * D, F.lane);
}

__device__ __forceinline__ bf16x8 lds_row8(const LAS bf16* p) { return *(const LAS bf16x8*)p; }
template <int PERM> __device__ __forceinline__ int prow(int r) { return PERM == 1 ? ((r & ~12) | ((r & 4) << 1) | ((r & 8) >> 1)) : PERM == 2 ? ((r & ~7) | ((r & 3) << 1) | ((r >> 2) & 1)) : r; }
template <int PERM>
__device__ __forceinline__ bf16x8 lds_tr8(const LAS bf16* img, int stride, int k0, int c0, int fr, int fq) {
    typedef short v4i16_t __attribute__((ext_vector_type(4)));
    const int q = fr >> 2, p = fr & 3;
    const int rlo = PERM == 1 ? 16 * (fq >> 1) + 4 * (fq & 1) + q : PERM == 2 ? 8 * fq + 2 * q : 8 * fq + q;
    constexpr int dhi = PERM == 1 ? 8 : PERM == 2 ? 1 : 4;
    const LAS bf16* a = img + (k0 + rlo) * stride + c0 + 4 * p;
    const s16x4 lo = __builtin_bit_cast(s16x4, __builtin_amdgcn_ds_read_tr16_b64_v4i16((LAS v4i16_t*)a));
    const s16x4 hi = __builtin_bit_cast(s16x4, __builtin_amdgcn_ds_read_tr16_b64_v4i16((LAS v4i16_t*)(a + dhi * stride)));
    return (bf16x8){lo.x, lo.y, lo.z, lo.w, hi.x, hi.y, hi.z, hi.w};
}
__device__ __forceinline__ f32x4 mfma16(bf16x8 a, bf16x8 b, f32x4 c) { return __builtin_amdgcn_mfma_f32_16x16x32_bf16(a, b, c, 0, 0, 0); }
__device__ __forceinline__ float softcap_f(float z) { const float e = __expf(z * (2.f / SOFTCAP)); return SOFTCAP * (1.f - 2.f / (e + 1.f)); }
__device__ __forceinline__ float logsigmoid_f(float x) { return fminf(x, 0.f) - __logf(1.f + __expf(-fabsf(x))); }
template <bool MAX>
__device__ __forceinline__ float dpp_scan(float v) {
    const int idn = MAX ? (int)0xff800000u : 0;
#define DPP_STEP(ctrl, rmask) do { const float t_ = __builtin_bit_cast(float, __builtin_amdgcn_update_dpp(idn, __builtin_bit_cast(int, v), ctrl, rmask, 0xf, false)); v = MAX ? fmaxf(v, t_) : v + t_; } while (0)
    DPP_STEP(0x111, 0xf); DPP_STEP(0x112, 0xf); DPP_STEP(0x114, 0xf); DPP_STEP(0x118, 0xf);
    DPP_STEP(0x142, 0xa); DPP_STEP(0x143, 0xc);
#undef DPP_STEP
    return v;
}
__device__ __forceinline__ float scan_add(float v, int lane) { (void)lane; return dpp_scan<false>(v); }
__device__ __forceinline__ float scan_max(float v, int lane) { (void)lane; return dpp_scan<true>(v); }
__device__ __forceinline__ void rot8(v4u& a, v4u& b, const GAS f32x4* cs) {
#pragma unroll
    for (int w = 0; w < 4; ++w) { const f32x4 t = cs[w]; const float x1l = bf_lo(a[w]), x1h = bf_hi(a[w]), x2l = bf_lo(b[w]), x2h = bf_hi(b[w]);
        a[w] = pk2(x1l * t.x - x2l * t.y, x1h * t.z - x2h * t.w); b[w] = pk2(x1l * t.y + x2l * t.x, x1h * t.w + x2h * t.z); }
}

__device__ __forceinline__ void rot8v(v4u& a, v4u& b, const f32x4 (&cs)[4]) {
#pragma unroll
    for (int w = 0; w < 4; ++w) { const f32x4 t = cs[w]; const float x1l = bf_lo(a[w]), x1h = bf_hi(a[w]), x2l = bf_lo(b[w]), x2h = bf_hi(b[w]);
        a[w] = pk2(x1l * t.x - x2l * t.y, x1h * t.z - x2h * t.w); b[w] = pk2(x1l * t.y + x2l * t.x, x1h * t.w + x2h * t.z); }
}
template <bool MLSTM, int DBG = 0>
__device__ __forceinline__ void prompt_chain(Frame& F, int unit) {
    constexpr int DK = MLSTM ? DKM : DKR, NDT = MLSTM ? 5 : 4, QS = DK + 16, VS = NDT * 16 + 8, PS = 80, NKT = DK / 128;
    constexpr int L_Q = 0, L_K = L_Q + 64 * QS * 2, L_V = L_K + 64 * QS * 2, L_P = L_V + 64 * VS * 2, L_C = L_P + 64 * PS * 2, L_ARR = L_C + DK * VS * 2;
    static_assert(L_ARR + 2 * 384 * 4 <= LDSCTL_OFF, "prompt chain LDS");
    LAS bf16* Qs = (LAS bf16*)(F.lds + L_Q); LAS bf16* Ks = (LAS bf16*)(F.lds + L_K); LAS bf16* Vx = (LAS bf16*)(F.lds + L_V); LAS bf16* Ps = (LAS bf16*)(F.lds + L_P); LAS bf16* Cb = (LAS bf16*)(F.lds + L_C);
    LAS float* a_g = (LAS float*)(F.lds + L_ARR); LAS float* a_Mx = a_g + 64; LAS float* a_iw = a_g + 128; LAS float* a_emt = a_g + 192; LAS float* a_w = a_g + 256; LAS float* a_sc = a_g + 320;
    int tid = F.tid; asm volatile("" : "+v"(tid));
    const int lane = tid & 63, wave = F.wave, fr = lane & 15, fq = lane >> 4;
    const int NSL = MLSTM ? 8 : 4, NH = MLSTM ? HM : HR;
    const int sl = unit % NSL, h = (unit / NSL) % NH, b = unit / (NSL * NH);
    const int qcol = (MLSTM ? PC_QM : PC_QR) + h * DK, kcol = (MLSTM ? PC_KM : PC_KR) + h * DK, vcol = (MLSTM ? PC_VM + h * DVM : PC_VR + h * DVR) + sl * 64;
    const int hcol = (MLSTM ? h * DVM : HM * DVM + h * DVR) + sl * 64;
    const bf16* proj = (const bf16*)(F.ws + WS_PROJ); const float* gates = (const float*)(F.ws + WS_GATES); bf16* hraw = (bf16*)(F.ws + WS_HRAW);
    float* ssq = (float*)(F.ws + WS_SSQ) + (MLSTM ? 0 : (size_t)M * 64);
    const GAS f32x4* rope = (const GAS f32x4*)(F.ws + WS_ROPE);
    for (int i = tid; i < DK * VS / 2; i += 512) ((LAS unsigned*)Cb)[i] = 0u;
    for (int i = tid; i < 64 * VS / 2; i += 512) ((LAS unsigned*)Vx)[i] = 0u;
    __syncthreads();
    if (MLSTM) { if (tid < 64) Vx[tid * VS + 64] = (bf16)0x3f80; }
    else if (tid < 64) {
        const float lg = logf(1.f - exp2f(-5.f - (float)h)), lsc = -0.5f * logf((float)DKR);
        a_g[tid] = -(float)tid * lg + lsc; a_Mx[tid] = -(float)tid * lg; a_iw[tid] = expf((float)(tid + 1) * lg); a_emt[tid] = 0.f; a_w[tid] = expf((float)(63 - tid) * lg + lsc);
        if (tid == 0) a_sc[0] = expf(64.f * lg);
    }
    f32x4 st[NKT][NDT];
#pragma unroll
    for (int kt = 0; kt < NKT; ++kt)
#pragma unroll
        for (int t = 0; t < NDT; ++t) st[kt][t] = (f32x4){0.f, 0.f, 0.f, 0.f};
    float m_run = 0.f;
    const float bi = MLSTM ? F.in[7][h] : 0.f, bfg = MLSTM ? F.in[8][h] : 0.f;
    v4u pq[4], pk[4], pv; f32x4 pcs[4]; float pig = 0.f, pfg = 0.f;
    const int rA = tid >> 3, cA8 = tid & 7;
#define CHAIN_LOAD(cn) do { const int row0n = b * SEQ + (cn) * 64; \
        if (MLSTM) { _Pragma("unroll") for (int i = 0; i < 4; ++i) { const int id = tid + 512 * i, r = id >> 5, cc = id & 31; \
                pq[i] = *(const GAS v4u*)(proj + (size_t)(row0n + r) * NPROJ + qcol + 8 * cc); pk[i] = *(const GAS v4u*)(proj + (size_t)(row0n + r) * NPROJ + kcol + 8 * cc); } \
            if (wave == 0) { pig = gates[(size_t)(row0n + lane) * 8 + h]; pfg = gates[(size_t)(row0n + lane) * 8 + 4 + h]; } } \
        else { const bf16* pr = proj + (size_t)(row0n + rA) * NPROJ + 8 * cA8; pq[0] = *(const GAS v4u*)(pr + qcol); pq[1] = *(const GAS v4u*)(pr + qcol + 64); pk[0] = *(const GAS v4u*)(pr + kcol); pk[1] = *(const GAS v4u*)(pr + kcol + 64); \
            const GAS f32x4* cs = rope + ((size_t)((cn) * 64 + rA) * 64 + 8 * cA8) / 2; _Pragma("unroll") for (int w = 0; w < 4; ++w) pcs[w] = cs[w]; } \
        pv = *(const GAS v4u*)(proj + (size_t)(row0n + rA) * NPROJ + vcol + 8 * cA8); } while (0)
#define CHAIN_STORE() do { \
        if (MLSTM) { _Pragma("unroll") for (int i = 0; i < 4; ++i) { const int id = tid + 512 * i, r = id >> 5, cc = id & 31; *(LAS v4u*)(Qs + r * QS + 8 * cc) = pq[i]; *(LAS v4u*)(Ks + prow<1>(r) * QS + 8 * cc) = pk[i]; } } \
        else { rot8v(pq[0], pq[1], pcs); rot8v(pk[0], pk[1], pcs); \
            *(LAS v4u*)(Qs + rA * QS + 8 * cA8) = pq[0]; *(LAS v4u*)(Qs + rA * QS + 64 + 8 * cA8) = pq[1]; *(LAS v4u*)(Ks + prow<1>(rA) * QS + 8 * cA8) = pk[0]; *(LAS v4u*)(Ks + prow<1>(rA) * QS + 64 + 8 * cA8) = pk[1]; } \
        *(LAS v4u*)(Vx + prow<2>(rA) * VS + 8 * cA8) = pv; } while (0)
#define CHAIN_GATES(ab) do { \
        const float li = softcap_f(pig + bi), lf = logsigmoid_f(softcap_f(pfg + bfg)); \
        const float bs = scan_add(lf, lane), g = li - bs, Gm = scan_max(g, lane), Mx = fmaxf(m_run, Gm); \
        const float MxL = __shfl(Mx, 63), bL = __shfl(bs, 63); \
        a_g[(ab) + lane] = g; a_Mx[(ab) + lane] = Mx; a_iw[(ab) + lane] = expf(m_run - Mx); a_emt[(ab) + lane] = expf(-(bs + Mx)); a_w[(ab) + lane] = expf(g - MxL); \
        if (lane == 0) a_sc[(ab)] = expf(m_run - MxL); \
        m_run = bL + MxL; } while (0)
    CHAIN_LOAD(0);
    CHAIN_STORE();
    if (MLSTM && wave == 0) CHAIN_GATES(0);
    for (int c = 0; c < SEQ / 64; ++c) {
        const int row0 = b * SEQ + c * 64;
        const int ab = MLSTM ? (c & 1) * 384 : 0, abn = MLSTM ? ((c + 1) & 1) * 384 : 0;
        const bool more = c + 1 < SEQ / 64;
        if (more && !(DBG & 16)) CHAIN_LOAD(c + 1);
        __syncthreads();
        constexpr int NKS = DK / 32;
        const int lt = wave & 3, hf = wave >> 2, l = 16 * lt + fr;
        bf16x8 qf[NKS];
#pragma unroll
        for (int ks = 0; ks < NKS; ++ks) qf[ks] = lds_row8(Qs + l * QS + 32 * ks + 8 * fq);
        if (!(DBG & 1)) {
            const float Mx = a_Mx[ab + l];
            f32x4 acc[2]; acc[0] = (f32x4){0.f, 0.f, 0.f, 0.f}; acc[1] = (f32x4){0.f, 0.f, 0.f, 0.f};
#pragma unroll
            for (int si = 0; si < 2; ++si) { bf16x8 kf[NKS];
#pragma unroll
                for (int ks = 0; ks < NKS; ++ks) kf[ks] = lds_row8(Ks + (16 * (2 * hf + si) + prow<1>(fr)) * QS + 32 * ks + 8 * fq);
#pragma unroll
                for (int ks = 0; ks < NKS; ++ks) acc[si] = mfma16(kf[ks], qf[ks], acc[si]); }
#pragma unroll
            for (int si = 0; si < 2; ++si) { const int stl = 2 * hf + si;
                const f32x4 gv = *(const LAS f32x4*)(a_g + ab + 16 * stl + 4 * fq); float p[4];
#pragma unroll
                for (int r = 0; r < 4; ++r) { const int s_ = 16 * stl + 4 * fq + r; p[r] = (s_ <= l) ? acc[si][r] * __expf(gv[r] - Mx) : 0.f; }
                v2u w; w.x = pk2(p[0], p[1]); w.y = pk2(p[2], p[3]); *(LAS v2u*)(Ps + l * PS + 16 * stl + 4 * fq) = w; }
        }
        if (MLSTM && wave == 0 && more) CHAIN_GATES(abn);
        __syncthreads();
        if (!(DBG & 2)) {
            constexpr int NT = MLSTM ? 3 : 2, NC = NKS / 2;
            f32x4 aQC[NT], aPV[NT];
#pragma unroll
            for (int t = 0; t < NT; ++t) { aQC[t] = (f32x4){0.f, 0.f, 0.f, 0.f}; aPV[t] = (f32x4){0.f, 0.f, 0.f, 0.f}; }
            bf16x8 fs[2][NT][2];
#define DVT(t) (16 * ((t) == 2 ? 4 : 2 * hf + (t)))
#define C_LOAD(set, ch) do { _Pragma("unroll") for (int t = 0; t < NT; ++t) _Pragma("unroll") for (int k = 0; k < 2; ++k) \
                fs[set][t][k] = ((ch) < NC) ? lds_tr8<2>(Cb, VS, 32 * (2 * (ch) + k), DVT(t), fr, fq) : lds_tr8<2>(Vx, VS, 32 * k, DVT(t), fr, fq); } while (0)
            C_LOAD(0, 0); C_LOAD(1, 1);
            const bf16x8 bp0 = lds_row8(Ps + l * PS + 8 * fq), bp1 = lds_row8(Ps + l * PS + 32 + 8 * fq);
            __builtin_amdgcn_sched_barrier(0);
#pragma unroll
            for (int ch = 0; ch <= NC; ++ch) {
                if (ch < NC) {
#pragma unroll
                    for (int k = 0; k < 2; ++k)
#pragma unroll
                        for (int t = 0; t < NT; ++t) aQC[t] = mfma16(fs[ch & 1][t][k], qf[2 * ch + k], aQC[t]);
                } else {
#pragma unroll
                    for (int t = 0; t < NT; ++t) { aPV[t] = mfma16(fs[ch & 1][t][0], bp0, aPV[t]); aPV[t] = mfma16(fs[ch & 1][t][1], bp1, aPV[t]); }
                }
                __builtin_amdgcn_sched_barrier(0);
                if (ch + 2 <= NC) { C_LOAD(ch & 1, ch + 2); __builtin_amdgcn_sched_barrier(0); }
            }
#undef C_LOAD
#undef DVT
            const float iw = a_iw[ab + l]; float inv = 1.f;
            if (MLSTM) { const float den = __shfl(iw * aQC[NT - 1][0] + aPV[NT - 1][0], fr); inv = 1.f / fmaxf(fabsf(den), a_emt[ab + l]); }
            float sq = 0.f;
#pragma unroll
            for (int t = 0; t < 2; ++t) { const f32x4 hv = (iw * aQC[t] + aPV[t]) * inv; sq += (hv.x * hv.x + hv.y * hv.y) + (hv.z * hv.z + hv.w * hv.w);
                v2u w; w.x = pk2(hv.x, hv.y); w.y = pk2(hv.z, hv.w); *(GAS v2u*)(hraw + (size_t)(row0 + l) * D + hcol + 16 * (2 * hf + t) + 4 * fq) = w; }
            sq += __shfl_xor(sq, 16); sq += __shfl_xor(sq, 32);
            if (fq == 0) ssq[(size_t)(row0 + l) * 64 + h * (MLSTM ? 16 : 8) + sl * 2 + hf] = sq;
        }
        if (!(DBG & 4)) {
            const float decay = a_sc[ab];
            bf16x8 bk[NKT][2], av[NDT][2];
#pragma unroll
            for (int t = 0; t < NDT; ++t)
#pragma unroll
                for (int ks = 0; ks < 2; ++ks) av[t][ks] = lds_tr8<2>(Vx, VS, 32 * ks, 16 * t, fr, fq);
#pragma unroll
            for (int ks = 0; ks < 2; ++ks) {
                const f32x4 w0 = *(const LAS f32x4*)(a_w + ab + 32 * ks + 8 * fq), w1 = *(const LAS f32x4*)(a_w + ab + 32 * ks + 8 * fq + 4);
#pragma unroll
                for (int kt = 0; kt < NKT; ++kt) { const bf16x8 raw = lds_tr8<1>(Ks, QS, 32 * ks, 16 * (NKT * wave + kt), fr, fq); v4u pk_;
                    pk_.x = pk2(__uint_as_float((unsigned)(unsigned short)raw[0] << 16) * w0.x, __uint_as_float((unsigned)(unsigned short)raw[1] << 16) * w0.y);
                    pk_.y = pk2(__uint_as_float((unsigned)(unsigned short)raw[2] << 16) * w0.z, __uint_as_float((unsigned)(unsigned short)raw[3] << 16) * w0.w);
                    pk_.z = pk2(__uint_as_float((unsigned)(unsigned short)raw[4] << 16) * w1.x, __uint_as_float((unsigned)(unsigned short)raw[5] << 16) * w1.y);
                    pk_.w = pk2(__uint_as_float((unsigned)(unsigned short)raw[6] << 16) * w1.z, __uint_as_float((unsigned)(unsigned short)raw[7] << 16) * w1.w);
                    bk[kt][ks] = __builtin_bit_cast(bf16x8, pk_); }
            }
#pragma unroll
            for (int kt = 0; kt < NKT; ++kt)
#pragma unroll
                for (int t = 0; t < NDT; ++t) st[kt][t] = st[kt][t] * decay;
#pragma unroll
            for (int ks = 0; ks < 2; ++ks)
#pragma unroll
                for (int t = 0; t < NDT; ++t)
#pragma unroll
                    for (int kt = 0; kt < NKT; ++kt) st[kt][t] = mfma16(av[t][ks], bk[kt][ks], st[kt][t]);
        }
        __syncthreads();
        if (!(DBG & 8))
#pragma unroll
        for (int kt = 0; kt < NKT; ++kt)
#pragma unroll
            for (int t = 0; t < NDT; ++t) { v2u w; w.x = pk2(st[kt][t].x, st[kt][t].y); w.y = pk2(st[kt][t].z, st[kt][t].w);
                *(LAS v2u*)(Cb + (16 * (NKT * wave + kt) + prow<2>(fr)) * VS + 16 * t + 4 * fq) = w; }
        if (more && !(DBG & 16)) CHAIN_STORE();
    }
#undef CHAIN_LOAD
#undef CHAIN_STORE
#undef CHAIN_GATES
    if (MLSTM) {
        float* Co = F.out + O_PC + (size_t)(b * HM + h) * DKM * DVM;
#pragma unroll
        for (int kt = 0; kt < NKT; ++kt) { const int dk = 16 * (NKT * wave + kt) + fr;
#pragma unroll
            for (int t = 0; t < 4; ++t) *(GAS f32x4*)(Co + (size_t)dk * DVM + sl * 64 + 16 * t + 4 * fq) = st[kt][t];
            if (sl == 0 && fq == 0) F.out[O_PN + (size_t)(b * HM + h) * DKM + dk] = st[kt][NDT - 1].x; }
        if (sl == 0 && tid == 0) F.out[O_PM + b * HM + h] = m_run;
    } else {
        float* So = F.out + O_PS + (size_t)(b * HR + h) * DKR * DVR;
#pragma unroll
        for (int kt = 0; kt < NKT; ++kt) { const int dk = 16 * (NKT * wave + kt) + fr;
#pragma unroll
            for (int t = 0; t < 4; ++t) *(GAS f32x4*)(So + (size_t)dk * DVR + sl * 64 + 16 * t + 4 * fq) = st[kt][t]; }
    }
    __syncthreads();
}

struct SuPre { v4u a, b, v; f32x4 cs[4]; float f0, f1, f2, f3; };
template <bool MLSTM>
__device__ __forceinline__ void su_issue(Frame& F, int unit, int tid, SuPre& p) {
    constexpr int DK = MLSTM ? DKM : DKR, DV = MLSTM ? DVM : DVR, NH = MLSTM ? HM : HR;
    const int lane = tid & 63, wave = F.wave, h = unit % NH, b = unit / NH, row0 = MP + b * DECT;
    const int qcol = (MLSTM ? PC_QM : PC_QR) + h * DK, kcol = (MLSTM ? PC_KM : PC_KR) + h * DK, vcol = MLSTM ? PC_VM + h * DVM : PC_VR + h * DVR;
    const bf16* proj = (const bf16*)(F.ws + WS_PROJ); const float* gates = (const float*)(F.ws + WS_GATES);
    if (MLSTM) {
        { const int which = tid >> 8, id = tid & 255, r = id >> 5, cc = id & 31; p.a = *(const GAS v4u*)(proj + (size_t)(row0 + r) * NPROJ + (which ? kcol : qcol) + 8 * cc); }
        { const int r = tid >> 6, cc = tid & 63; p.v = *(const GAS v4u*)(proj + (size_t)(row0 + r) * NPROJ + vcol + 8 * cc); }
        p.f0 = (tid < DK) ? F.in[3][(size_t)(b * HM + h) * DKM + tid] : 0.f;
        if (wave == 7) { const int t = lane & 7; p.f1 = gates[(size_t)(row0 + t) * 8 + h]; p.f2 = gates[(size_t)(row0 + t) * 8 + 4 + h]; p.f3 = F.in[4][b * HM + h]; }
    } else {
        if (tid < 128) { const int which = tid >> 6, id = tid & 63, r = id >> 3, cc = id & 7; const int col = which ? kcol : qcol;
            const GAS f32x4* cs = (const GAS f32x4*)(F.ws + WS_ROPE) + ((size_t)(2048 + r) * 64 + 8 * cc) / 2;
            p.a = *(const GAS v4u*)(proj + (size_t)(row0 + r) * NPROJ + col + 8 * cc); p.b = *(const GAS v4u*)(proj + (size_t)(row0 + r) * NPROJ + col + 64 + 8 * cc);
#pragma unroll
            for (int w = 0; w < 4; ++w) p.cs[w] = cs[w]; }
        if (tid < 256) { const int r = tid >> 5, cc = tid & 31; p.v = *(const GAS v4u*)(proj + (size_t)(row0 + r) * NPROJ + vcol + 8 * cc); }
    }
}
template <bool MLSTM>
__device__ __forceinline__ int sample_unit(Frame& F, int unit, SuPre& p, gu32* qword, unsigned nunits, volatile LAS unsigned* qslot) {
    constexpr int DK = MLSTM ? DKM : DKR, DV = MLSTM ? DVM : DVR, NH = MLSTM ? HM : HR, NCG = DV / 4, NPART = 512 / NCG, RPP = DK / NPART, DPT = DV / 64;
    constexpr int L_QF = 0, L_KF = L_QF + DK * 32, L_KW = L_KF + DK * 32, L_VF = L_KW + DK * 32, L_NF = L_VF + 8 * DV * 4, L_SM = L_NF + DK * 4, L_NP = L_SM + 1024;
    static_assert(L_NP + NPART * 8 * DV * 4 <= LDSCTL_OFF, "sample unit LDS");
    LAS float* qf = (LAS float*)(F.lds + L_QF); LAS float* kf = (LAS float*)(F.lds + L_KF); LAS float* kwf = (LAS float*)(F.lds + L_KW); LAS float* vf = (LAS float*)(F.lds + L_VF);
    LAS float* nf = (LAS float*)(F.lds + L_NF); LAS float* sm = (LAS float*)(F.lds + L_SM); LAS float* np = (LAS float*)(F.lds + L_NP);
    LAS float* s_g = sm, *s_Mx = sm + 8, *s_iw = sm + 16, *s_emt = sm + 24, *s_w = sm + 32, *s_sc = sm + 40, *s_qn = sm + 48, *s_inv = sm + 56, *s_P = sm + 64;
    int tid = F.tid; asm volatile("" : "+v"(tid));
    const int lane = tid & 63, wave = F.wave;
    const int h = unit % NH, b = unit / NH, row0 = MP + b * DECT;
    const int qcol = (MLSTM ? PC_QM : PC_QR) + h * DK, kcol = (MLSTM ? PC_KM : PC_KR) + h * DK, vcol = MLSTM ? PC_VM + h * DVM : PC_VR + h * DVR;
    const int hcol = MLSTM ? h * DVM : HM * DVM + h * DVR;
    const bf16* proj = (const bf16*)(F.ws + WS_PROJ); const float* gates = (const float*)(F.ws + WS_GATES); bf16* hraw = (bf16*)(F.ws + WS_HRAW);
    float* ssq = (float*)(F.ws + WS_SSQ) + (MLSTM ? 0 : (size_t)M * 64);
    const float* S0 = MLSTM ? F.in[2] + (size_t)(b * HM + h) * DKM * DVM : F.in[5] + (size_t)(b * HR + h) * DKR * DVR;
    float* S1 = MLSTM ? F.out + O_SC + (size_t)(b * HM + h) * DKM * DVM : F.out + O_SS + (size_t)(b * HR + h) * DKR * DVR;
    constexpr int QBS = DK + 8; LAS bf16* qb = (LAS bf16*)(F.lds + L_NP); LAS bf16* kb = qb + 8 * QBS;
    if (tid == 0) qslot[0] = __hip_atomic_fetch_add(qword, 1u, RLX_AGENT);
    if (MLSTM) {
        { const int which = tid >> 8, id = tid & 255, r = id >> 5, cc = id & 31; const v4u x = p.a; LAS float* dst = which ? kf : qf;
            *(LAS v4u*)((which ? kb : qb) + r * QBS + 8 * cc) = x;
#pragma unroll
            for (int w = 0; w < 4; ++w) { dst[(8 * cc + 2 * w) * 8 + r] = bf_lo(x[w]); dst[(8 * cc + 2 * w + 1) * 8 + r] = bf_hi(x[w]); } }
    } else {
        if (tid < 128) { const int which = tid >> 6, id = tid & 63, r = id >> 3, cc = id & 7;
            v4u x1 = p.a, x2 = p.b; rot8v(x1, x2, p.cs); LAS float* dst = which ? kf : qf;
            *(LAS v4u*)((which ? kb : qb) + r * QBS + 8 * cc) = x1; *(LAS v4u*)((which ? kb : qb) + r * QBS + 64 + 8 * cc) = x2;
#pragma unroll
            for (int w = 0; w < 4; ++w) { dst[(8 * cc + 2 * w) * 8 + r] = bf_lo(x1[w]); dst[(8 * cc + 2 * w + 1) * 8 + r] = bf_hi(x1[w]);
                dst[(64 + 8 * cc + 2 * w) * 8 + r] = bf_lo(x2[w]); dst[(64 + 8 * cc + 2 * w + 1) * 8 + r] = bf_hi(x2[w]); } }
    }
    if (tid < 8 * DV / 8) { const int r = tid / (DV / 8), cc = tid % (DV / 8); const v4u x = p.v;
#pragma unroll
        for (int w = 0; w < 4; ++w) { vf[r * DV + 8 * cc + 2 * w] = bf_lo(x[w]); vf[r * DV + 8 * cc + 2 * w + 1] = bf_hi(x[w]); } }
    if (MLSTM) { if (tid < DK) nf[tid] = p.f0; }
    if (wave == 7) {
        if (MLSTM) {
            const float m0 = p.f3;
            const float ig = p.f1, fg = p.f2;
            const float li = softcap_f(ig + F.in[7][h]), lf = logsigmoid_f(softcap_f(fg + F.in[8][h]));
            float bs = lf, Gm;
#pragma unroll
            for (int o = 1; o < 8; o <<= 1) { const float tt = __shfl_up(bs, o); if ((lane & 7) >= o) bs += tt; }
            const float g = li - bs; Gm = g;
#pragma unroll
            for (int o = 1; o < 8; o <<= 1) { const float tt = __shfl_up(Gm, o); if ((lane & 7) >= o) Gm = fmaxf(Gm, tt); }
            const float Mx = fmaxf(m0, Gm), MxL = __shfl(Mx, 7), bL = __shfl(bs, 7);
            if (lane < 8) { s_g[lane] = g; s_Mx[lane] = Mx; s_iw[lane] = expf(m0 - Mx); s_emt[lane] = expf(-(bs + Mx)); s_w[lane] = expf(g - MxL); }
            if (lane == 0) { s_sc[0] = expf(m0 - MxL); F.out[O_SM + b * HM + h] = bL + MxL; }
        } else if (lane < 8) {
            const float lg = logf(1.f - exp2f(-5.f - (float)h)), lsc = -0.5f * logf((float)DKR);
            s_g[lane] = -(float)lane * lg + lsc; s_Mx[lane] = -(float)lane * lg; s_iw[lane] = expf((float)(lane + 1) * lg); s_emt[lane] = 0.f; s_w[lane] = expf((float)(7 - lane) * lg + lsc);
            if (lane == 0) s_sc[0] = expf(8.f * lg);
        }
    }
    __syncthreads();
    if (wave == 0) {
        const int fr = lane & 15, fq = lane >> 4; const bf16x8 z8 = (bf16x8){0, 0, 0, 0, 0, 0, 0, 0}; f32x4 d = (f32x4){0.f, 0.f, 0.f, 0.f};
#pragma unroll
        for (int ks = 0; ks < DK / 32; ++ks) { const bf16x8 a = lds_row8(qb + (fr & 7) * QBS + 32 * ks + 8 * fq), bb = lds_row8(kb + (fr & 7) * QBS + 32 * ks + 8 * fq);
            d = mfma16(fr < 8 ? a : z8, fr < 8 ? bb : z8, d); }
        if (fr < 8 && fq < 2) {
#pragma unroll
            for (int r = 0; r < 4; ++r) { const int l = 4 * fq + r; s_P[l * 8 + fr] = (fr <= l) ? d[r] * __expf(s_g[fr] - s_Mx[l]) : 0.f; } }
    }
    for (int i = tid; i < DK * 8; i += 512) kwf[i] = kf[i] * s_w[i & 7];
    if (MLSTM) { float a = 0.f; for (int dk = lane; dk < DK; dk += 64) a += qf[dk * 8 + wave] * nf[dk]; a = wave_sum(a); if (lane == 0) s_qn[wave] = a; }
    __syncthreads();
    const unsigned un = qslot[0];
    if (un < nunits) su_issue<MLSTM>(F, (int)un, tid, p);
    if (MLSTM) {
        if (tid < 8) { float den = s_iw[tid] * s_qn[tid]; for (int s = 0; s < 8; ++s) den += s_P[tid * 8 + s]; s_inv[tid] = 1.f / fmaxf(fabsf(den), s_emt[tid]); }
        if (tid < DK) { float a = s_sc[0] * nf[tid]; for (int s = 0; s < 8; ++s) a += kwf[tid * 8 + s]; F.out[O_SN + (size_t)(b * HM + h) * DKM + tid] = a; }
    } else if (tid < 8) s_inv[tid] = 1.f;
    {
        const int part = __builtin_amdgcn_readfirstlane(tid / NCG), cg = tid % NCG; const float decay = s_sc[0];
        f32x4 vv[8], num[8];
#pragma unroll
        for (int s = 0; s < 8; ++s) { vv[s] = *(const LAS f32x4*)(vf + s * DV + 4 * cg); num[s] = (f32x4){0.f, 0.f, 0.f, 0.f}; }
        const GAS char* srcb = (const GAS char*)(S0 + (size_t)(part * RPP) * DV); GAS char* dstb = (GAS char*)(S1 + (size_t)(part * RPP) * DV); const unsigned vo = (unsigned)cg * 16u;
#define SU_LOAD(buf, r0) do { _Pragma("unroll") for (int j = 0; j < 4; ++j) buf[j] = __builtin_nontemporal_load((const GAS f32x4*)(srcb + (size_t)((r0) + j) * (DV * 4) + vo)); } while (0)
#define SU_COMP(buf, r0) do { _Pragma("unroll") for (int j = 0; j < 4; ++j) { const int dk = part * RPP + (r0) + j; \
                const f32x4 q0 = *(const LAS f32x4*)(qf + dk * 8), q1 = *(const LAS f32x4*)(qf + dk * 8 + 4), k0 = *(const LAS f32x4*)(kwf + dk * 8), k1 = *(const LAS f32x4*)(kwf + dk * 8 + 4); \
                const f32x4 c0 = buf[j]; f32x4 cn = c0 * decay; \
                num[0] += q0.x * c0; num[1] += q0.y * c0; num[2] += q0.z * c0; num[3] += q0.w * c0; num[4] += q1.x * c0; num[5] += q1.y * c0; num[6] += q1.z * c0; num[7] += q1.w * c0; \
                cn += k0.x * vv[0]; cn += k0.y * vv[1]; cn += k0.z * vv[2]; cn += k0.w * vv[3]; cn += k1.x * vv[4]; cn += k1.y * vv[5]; cn += k1.z * vv[6]; cn += k1.w * vv[7]; \
                __builtin_nontemporal_store(cn, (GAS f32x4*)(dstb + (size_t)((r0) + j) * (DV * 4) + vo)); } } while (0)
        static_assert(RPP % 4 == 0 && RPP >= 8, "sample unit row batches");
        f32x4 ca[4], cb[4], cc[4];
        SU_LOAD(ca, 0); SU_LOAD(cb, 4);
        for (int i0 = 0; i0 < RPP; i0 += 12) {
            if (i0 + 8 < RPP) SU_LOAD(cc, i0 + 8);
            SU_COMP(ca, i0);
            if (i0 + 12 < RPP) SU_LOAD(ca, i0 + 12);
            if (i0 + 4 < RPP) SU_COMP(cb, i0 + 4);
            if (i0 + 16 < RPP) SU_LOAD(cb, i0 + 16);
            if (i0 + 8 < RPP) SU_COMP(cc, i0 + 8);
        }
#undef SU_LOAD
#undef SU_COMP
#pragma unroll
        for (int l = 0; l < 8; ++l) *(LAS f32x4*)(np + (size_t)(part * 8 + l) * DV + 4 * cg) = num[l];
    }
    __syncthreads();
    { const int l = wave, dv0 = lane * DPT; const float iw = s_iw[l], inv = s_inv[l]; float hv[DPT]; float sq = 0.f;
#pragma unroll
      for (int j = 0; j < DPT; ++j) { float a = 0.f;
#pragma unroll
          for (int p = 0; p < NPART; ++p) a += np[(size_t)(p * 8 + l) * DV + dv0 + j];
          a *= iw;
#pragma unroll
          for (int s = 0; s < 8; ++s) a += s_P[l * 8 + s] * vf[s * DV + dv0 + j];
          a *= inv; hv[j] = a; sq += a * a; }
      bf16* o = hraw + (size_t)(row0 + l) * D + hcol + dv0;
      if (DPT == 8) { v4u w; w.x = pk2(hv[0], hv[1]); w.y = pk2(hv[2], hv[3]); w.z = pk2(hv[4], hv[5]); w.w = pk2(hv[6], hv[7]); *(GAS v4u*)o = w; }
      else { v2u w; w.x = pk2(hv[0], hv[1]); w.y = pk2(hv[2], hv[3]); *(GAS v2u*)o = w; }
      sq = wave_sum(sq);
      constexpr int NSLOT = MLSTM ? 16 : 8;
      if (lane < NSLOT) ssq[(size_t)(row0 + l) * 64 + h * NSLOT + lane] = (lane == 0) ? sq : 0.f; }
    __syncthreads();
    return un < nunits ? (int)un : -1;
}
template <bool MLSTM>
__device__ __forceinline__ void sample_loop(Frame& F, gu32* qword, unsigned nunits, volatile LAS unsigned* qslot) {
    if (F.tid == 0) qslot[0] = __hip_atomic_fetch_add(qword, 1u, RLX_AGENT);
    __syncthreads();
    int u = (int)qslot[0];
    __syncthreads();
    if ((unsigned)u >= nunits) return;
    SuPre p; su_issue<MLSTM>(F, u, F.tid, p);
    while (u >= 0) u = sample_unit<MLSTM>(F, u, p, qword, nunits, qslot);
}

#ifndef P2_STREAM_ONLY_MOD
#define P2_STREAM_ONLY_MOD 0
#endif
__device__ __forceinline__ void p2_mixers(Frame& F, int rep) {
    volatile LAS unsigned* qslot = F.MISC + 16;
#ifdef CHAIN_DBG
    if (rep == 1) {
        for (;;) {
            if (F.tid == 0) qslot[0] = __hip_atomic_fetch_add(F.ctl + CW_QUEUE + 64 * 3, 1u, RLX_AGENT);
            __syncthreads();
            const unsigned u = qslot[0];
            __syncthreads();
            if (u >= 256u) break;
            if (u < 128u) prompt_chain<true, CHAIN_DBG>(F, (int)u); else prompt_chain<false, CHAIN_DBG>(F, (int)u - 128);
        }
        return;
    }
#endif
    const bool chain_ok = (P2_STREAM_ONLY_MOD == 0) || ((int)blockIdx.x % (P2_STREAM_ONLY_MOD ? P2_STREAM_ONLY_MOD : 1)) != 0;
    if (chain_ok && !(PROBE_REPEAT == 21 && rep == 1)) for (;;) {
        if (F.tid == 0) qslot[0] = __hip_atomic_fetch_add(F.ctl + CW_QUEUE + 64 * (2 + rep), 1u, RLX_AGENT);
        __syncthreads();
        const unsigned u = qslot[0];
        __syncthreads();
        if (u >= 256u) break;
        if (u < 128u) prompt_chain<true>(F, (int)u); else prompt_chain<false>(F, (int)u - 128);
    }
    sample_loop<true>(F, F.ctl + CW_QUEUE + 64 * rep, 512u, qslot);
    sample_loop<false>(F, F.ctl + CW_QUEUE + 64 * (4 + rep), 1024u, qslot);
}

__device__ __forceinline__ void p3_norm_gate(Frame& F) {
    const int gw = F.vcu * NWAVES + F.wave, NGW = F.G * NWAVES, lane = F.lane;
    const bf16* proj = (const bf16*)(F.ws + WS_PROJ); const bf16* hraw = (const bf16*)(F.ws + WS_HRAW); bf16* cat = (bf16*)(F.ws + WS_CAT);
    const float* ssq_m = (const float*)(F.ws + WS_SSQ); const float* ssq_r = ssq_m + (size_t)M * 64;
    f32x4 gg[8][2];
#pragma unroll
    for (int i = 0; i < 8; ++i) { const int col = 8 * lane + 512 * i; const float* gp = (i < 4) ? F.in[9] + col : F.in[10] + (col - 2048); gg[i][0] = *(const GAS f32x4*)gp; gg[i][1] = *(const GAS f32x4*)(gp + 4); }
    for (int m = gw; m < M; m += NGW) {
        float sm = ssq_m[(size_t)m * 64 + lane], sr = ssq_r[(size_t)m * 64 + lane];
        v4u hx[8], gx[8];
#pragma unroll
        for (int i = 0; i < 8; ++i) { const int col = 8 * lane + 512 * i; hx[i] = *(const GAS v4u*)(hraw + (size_t)m * D + col); gx[i] = *(const GAS v4u*)(proj + (size_t)m * NPROJ + (i < 4 ? PC_OM + col : PC_GR + (col - 2048))); }
        sm += __shfl_xor(sm, 1); sm += __shfl_xor(sm, 2); sm += __shfl_xor(sm, 4); sm += __shfl_xor(sm, 8);
        sr += __shfl_xor(sr, 1); sr += __shfl_xor(sr, 2); sr += __shfl_xor(sr, 4);
        const float rm = 1.f / sqrtf(sm * (1.f / DVM) + RMS_EPS), rr = 1.f / sqrtf(sr * (1.f / DVR) + RMS_EPS);
#pragma unroll
        for (int i = 0; i < 8; ++i) {
            const int col = 8 * lane + 512 * i;
            float rs;
            if (i < 4) rs = __shfl(rm, 16 * i);
            else { const float r0 = __shfl(rr, 16 * (i - 4)), r1 = __shfl(rr, 16 * (i - 4) + 8); rs = lane < 32 ? r0 : r1; }
            const float g8[8] = {gg[i][0].x, gg[i][0].y, gg[i][0].z, gg[i][0].w, gg[i][1].x, gg[i][1].y, gg[i][1].z, gg[i][1].w};
            v4u o;
#pragma unroll
            for (int w = 0; w < 4; ++w) { const float h0 = bf_lo(hx[i][w]), h1 = bf_hi(hx[i][w]), z0 = bf_lo(gx[i][w]), z1 = bf_hi(gx[i][w]);
                const float s0 = 1.f / (1.f + __expf(-z0)), s1 = 1.f / (1.f + __expf(-z1));
                const float a0 = (i < 4) ? s0 : z0 * s0, a1 = (i < 4) ? s1 : z1 * s1;
                o[w] = pk2(h0 * rs * g8[2 * w] * a0, h1 * rs * g8[2 * w + 1] * a1); }
            *(GAS v4u*)(cat + (size_t)m * D + col) = o;
        }
    }
}

struct Args { const float* in[17]; float* out; unsigned char* ws; int ph_lo, ph_hi; };
__global__ void __launch_bounds__(NWAVES * 64, 2) hymba_fwd(Args args) {
    extern __shared__ __attribute__((aligned(16))) unsigned char lds[];
    Frame F;
    F.lds = (LAS unsigned char*)lds;
    F.MISC = (volatile LAS unsigned*)(F.lds + MISC_OFF);
    F.tid = threadIdx.x; F.lane = F.tid & 63; F.wave = __builtin_amdgcn_readfirstlane(F.tid >> 6);
    F.G = gridDim.x; { const int bx = blockIdx.x; F.vcu = (F.G % 8 == 0) ? (bx % 8) * (F.G / 8) + bx / 8 : bx; }
#pragma unroll
    for (int i = 0; i < 17; ++i) F.in[i] = args.in[i];
    F.out = args.out; F.ws = args.ws;
    F.ctl = (gu32*)(F.ws + WS_CTL);
    for (int u = F.tid; u < (LDS_BYTES - LDSCTL_OFF) / 4; u += NWAVES * 64) ((LAS unsigned*)(F.lds + LDSCTL_OFF))[u] = 0u;
    __syncthreads();
    XcdBarrier bar; bar.bar = (unsigned*)(F.ctl + CW_BAR); bar.x = 0; bar.st = nullptr;
    if (N_LAUNCHES == 1) bar = xcd_barrier_post((unsigned*)(F.ctl + CW_BAR), F.MISC + 8);
#define GRID_BAR() do { if (N_LAUNCHES == 1) xcd_barrier(bar); } while (0)
    const int lo = args.ph_lo, hi = args.ph_hi;
#define IN(k) (lo <= (k) && (k) < hi)
#define BOTH(k) (IN(k) && IN((k) + 1))
    bf16* XN = (bf16*)(F.ws + WS_XN);
#define RUN2(k, body) do { body; if (PROBE_REPEAT == (k)) { GRID_BAR(); body; } } while (0)
    if (IN(0)) { RUN2(0, p0_prologue(F)); if (BOTH(0)) GRID_BAR(); }
    if (IN(1)) {
        pg8::Gemm g{XN, (const bf16*)(F.ws + WS_WIN), M, NPROJ_PAD, D, D}; pg8::StaticOrder S; S.init(M, NPROJ_PAD, F.G, (int)blockIdx.x);
        pg8::EpiProj E{(bf16*)(F.ws + WS_PROJ), NPROJ, (float*)(F.ws + WS_GATES), NPROJ / 256, 4, 0.0625f};
        typedef pg8::WFill<D, FF> WF; const int f0 = (int)((long long)F.vcu * WF::NI / F.G), f1 = (int)((long long)(F.vcu + 1) * WF::NI / F.G);
        WF FL{F.in[14], F.in[15], (bf16*)(F.ws + WS_WUP), (bf16*)(F.ws + WS_WDN), __builtin_amdgcn_readfirstlane(f0), __builtin_amdgcn_readfirstlane(f1),
              __builtin_amdgcn_readfirstlane(f1 > f0 ? f0 + (F.vcu * 37) % (f1 - f0) : f0), __builtin_amdgcn_readfirstlane(f0), __builtin_amdgcn_readfirstlane(f1), nullptr, nullptr, 0u, 0u};
        RUN2(1, (pg8::gemm_phase<pg8::EpiProj, pg8::StaticOrder, true, true, WF>(F.lds, g, S, E, FL)));
        if (BOTH(1)) GRID_BAR();
    }
    if (IN(2)) {
#ifdef CHAIN_DBG
        p2_mixers(F, 1); GRID_BAR();
#endif
        p2_mixers(F, 0); if (PROBE_REPEAT == 2 || PROBE_REPEAT == 21) { GRID_BAR(); p2_mixers(F, 1); } if (BOTH(2)) GRID_BAR(); }
    if (IN(3)) { RUN2(3, p3_norm_gate(F)); if (BOTH(3)) GRID_BAR(); }
    bf16* X1B = (bf16*)(F.ws + WS_X1B); float* rowssq = (float*)(F.ws + WS_CTL) + CW_ROWSSQ;
    if (IN(4)) {
        pg8::Gemm g{(const bf16*)(F.ws + WS_CAT), (const bf16*)(F.ws + WS_WOUT), MP, D, D, D}; pg8::StaticOrder S; S.init(MP, D, F.G, (int)blockIdx.x);
        pg8::EpiX1 E{F.in[0], F.in[13], X1B, XN, D, D, rowssq};
        pg8::Gemm g2{(const bf16*)(F.ws + WS_CAT), (const bf16*)(F.ws + WS_WOUT), M, D, D / 4, D}; pg8::SplitTailOrder S2{MP / 256, D / 4, F.G, (int)blockIdx.x};
        pg8::EpiPartF32 E2{(float*)(F.ws + WS_PART), D, MP / 256, D / 4, (size_t)MS * D};
        pg8::gemm_phase<pg8::EpiX1, pg8::StaticOrder, true, true>(F.lds, g, S, E);
        pg8::gemm_phase<pg8::EpiPartF32, pg8::SplitTailOrder, true, true>(F.lds, g2, S2, E2);
        if (BOTH(4)) GRID_BAR();
    }
    if (IN(5)) { const int gw = F.vcu * NWAVES + F.wave, NGW = F.G * NWAVES;
        for (int m = MP + gw; m < M; m += NGW) x1_sample_row(F.in[1] + (size_t)(m - MP) * D, (const float*)(F.ws + WS_PART) + (size_t)(m - MP) * D, (size_t)MS * D, F.in[13], X1B + (size_t)m * D, XN + (size_t)m * D, rowssq + m, F.lane);
        if (BOTH(5)) GRID_BAR(); }
    if (IN(6)) {
        pg8::Gemm g{XN, (const bf16*)(F.ws + WS_WUP), M, FF, D, D}; pg8::StaticOrder S; S.init(M, FF, F.G, (int)blockIdx.x);
        pg8::EpiRelu2S E{(bf16*)(F.ws + WS_U), FF, rowssq, 1.f / D, RMS_EPS};
        pg8::gemm_phase<pg8::EpiRelu2S, pg8::StaticOrder, true, true>(F.lds, g, S, E);
        if (BOTH(6)) GRID_BAR();
    }
    if (IN(7)) {
        pg8::Gemm g{(const bf16*)(F.ws + WS_U), (const bf16*)(F.ws + WS_WDN), MP, D, FF, FF}; pg8::StaticOrder S; S.init(MP, D, F.G, (int)blockIdx.x);
        pg8::EpiX2 E{X1B, D};
        pg8::Gemm g2{(const bf16*)(F.ws + WS_U), (const bf16*)(F.ws + WS_WDN), M, D, FF / 4, FF}; pg8::SplitTailOrder S2{MP / 256, FF / 4, F.G, (int)blockIdx.x};
        pg8::EpiPartF32 E2{(float*)(F.ws + WS_PART), D, MP / 256, FF / 4, (size_t)MS * D};
        pg8::gemm_phase<pg8::EpiX2, pg8::StaticOrder, true, true>(F.lds, g, S, E);
        pg8::gemm_phase<pg8::EpiPartF32, pg8::SplitTailOrder, true, true>(F.lds, g2, S2, E2);
        if (BOTH(7)) GRID_BAR();
    }
    if (IN(8)) { const int gw = F.vcu * NWAVES + F.wave, NGW = F.G * NWAVES; const float* gfin = F.in[16]; const float* partb = (const float*)(F.ws + WS_PART);
        for (int rep8 = 0; rep8 < (PROBE_REPEAT == 8 ? 2 : 1); ++rep8) {
        v2u cur[16], nxt[16];
        if (NGW == 2048) {
            int r0, nr;
            if (gw < 1024) { const int m = MP + gw; frow_load(cur, X1B + (size_t)m * D, F.lane); frow_finish<true>(cur, partb + (size_t)(m - MP) * D, (size_t)MS * D, gfin, F.out + O_Y + (size_t)m * D, F.lane); r0 = 2 * gw; nr = 2; }
            else { r0 = 2048 + (gw - 1024) * 6; nr = 6; }
            frow_load(cur, X1B + (size_t)r0 * D, F.lane);
            for (int i = 0; i < nr; ++i) { const int m = r0 + i;
                if (i + 1 < nr) frow_load(nxt, X1B + (size_t)(m + 1) * D, F.lane);
                frow_finish<false>(cur, nullptr, 0, gfin, F.out + O_Y + (size_t)m * D, F.lane);
#pragma unroll
                for (int j = 0; j < 16; ++j) cur[j] = nxt[j]; }
        } else {
            for (int m = gw; m < M; m += NGW) { frow_load(cur, X1B + (size_t)m * D, F.lane);
                if (m < MP) frow_finish<false>(cur, nullptr, 0, gfin, F.out + O_Y + (size_t)m * D, F.lane);
                else frow_finish<true>(cur, partb + (size_t)(m - MP) * D, (size_t)MS * D, gfin, F.out + O_Y + (size_t)m * D, F.lane); }
        } } }
#undef RUN2
#undef IN
#undef BOTH
}

extern "C" void kernel_launch(void* const* d_in, const int* in_sizes, int n_in, void* d_out, int out_size, void* d_ws, size_t ws_size, hipStream_t stream) {
    static int grid = 0;
    if (grid == 0) {
        if (n_in != 17 || in_sizes[0] != MP * D || (size_t)out_size != O_END || ws_size < WS_END) { fprintf(stderr, "kernel_launch: unexpected shapes: n_in %d in0 %d out %d ws %zu (need %zu); nothing launched\n", n_in, n_in > 0 ? in_sizes[0] : -1, out_size, ws_size, (size_t)WS_END); grid = -1; return; }
        int dev = 0, cus = 0, per_cu = 0;
        if (hipGetDevice(&dev) != hipSuccess || hipDeviceGetAttribute(&cus, hipDeviceAttributeMultiprocessorCount, dev) != hipSuccess) { fprintf(stderr, "kernel_launch: device query failed\n"); grid = -1; return; }
        if (hipFuncSetAttribute((const void*)hymba_fwd, hipFuncAttributeMaxDynamicSharedMemorySize, LDS_BYTES) != hipSuccess) { fprintf(stderr, "kernel_launch: hipFuncSetAttribute(%d B LDS) failed\n", LDS_BYTES); grid = -1; return; }
        if (hipOccupancyMaxActiveBlocksPerMultiprocessor(&per_cu, (const void*)hymba_fwd, NWAVES * 64, LDS_BYTES) != hipSuccess || per_cu < 1)
            fprintf(stderr, "kernel_launch: note: occupancy query reports %d workgroups per CU\n", per_cu);
        (void)hipGetLastError();
        grid = cus;
    }
    if (grid < 0) return;
    if (hipMemsetAsync((char*)d_ws + WS_CTL, 0, CTL_ZERO_BYTES, stream) != hipSuccess) { fprintf(stderr, "kernel_launch: memset failed\n"); return; }
    Args a{};
    for (int i = 0; i < 17; ++i) a.in[i] = (const float*)d_in[i];
    a.out = (float*)d_out; a.ws = (unsigned char*)d_ws;
    for (int li = 0; li < N_LAUNCHES; ++li) {
        a.ph_lo = (N_LAUNCHES == 1) ? 0 : li; a.ph_hi = (N_LAUNCHES == 1) ? N_PHASES : li + 1;
        hipLaunchKernelGGL(hymba_fwd, dim3(grid), dim3(NWAVES * 64), LDS_BYTES, stream, a);
        const hipError_t le = hipPeekAtLastError();
        if (le != hipSuccess) { fprintf(stderr, "kernel_launch: launch %d failed: %s\n", li, hipGetErrorName(le)); break; }
    }
}
```

```cpp
#include <hip/hip_runtime.h>
#include <cstdio>
#include <cstdint>
namespace pg8 {
#define PG8_LAS __attribute__((address_space(3)))
typedef unsigned short bf16_t;
typedef short bf16x8 __attribute__((ext_vector_type(8)));
typedef float f32x4 __attribute__((ext_vector_type(4)));
typedef unsigned u32x4 __attribute__((ext_vector_type(4)));
constexpr int BM = 256, BK = 64, HALF = 128, HTB = HALF * BK * 2  , STAGE_BYTES = 8 * HTB, NXCD = 8, WGM = 8;

__host__ __device__ __forceinline__ int lds_byte(int r, int c) { const int st = (r >> 4) * 2 + (c >> 5), rr = r & 15, cc = c & 31, ob = rr * 64 + cc * 2; return st * 1024 + (ob ^ (((ob >> 9) & 1) << 5)); }
__host__ __device__ __forceinline__ void stage_rc(int b, int& R, int& C) { const int st = b / 1024, sb = b % 1024, swz = sb ^ (((sb >> 9) & 1) << 5); R = (st >> 1) * 16 + swz / 64; C = (st & 1) * 32 + (swz % 64) / 2; }
__host__ __device__ __forceinline__ int perm32(int rho) { const int n = rho >> 4, i = rho & 15; return 8 * (i >> 2) + 4 * n + (i & 3); }

struct Unit { int pm, pn, k0; };
struct Gemm { const bf16_t* A; const bf16_t* Bt; int M, N, K, ld; };

struct StaticOrder {
    int nM, nN, nwg, G, c, wgm;
    __host__ __device__ void init(int M, int N, int G_, int c_) { nM = M / BM; nN = N / BM; nwg = nM * nN; G = G_; c = c_; wgm = (nM % 8 != 0 && nM % 6 == 0) ? 6 : WGM; }
    __host__ __device__ bool next(int i, Unit& u) const {
        const long L = (long)i * G + c; if (L >= nwg) return false;
        int wgid = (int)L; { const int q = nwg / NXCD, r = nwg % NXCD, xcd = wgid % NXCD, off = wgid / NXCD; wgid = (xcd < r ? xcd * (q + 1) : r * (q + 1) + (xcd - r) * q) + off; }
        const int nig = wgm * nN, gid = wgid / nig, fm = gid * wgm, gsz = (nM - fm) < wgm ? (nM - fm) : wgm;
        u.pm = fm + ((wgid % nig) % gsz); u.pn = (wgid % nig) / gsz; u.k0 = 0; return true;
    }
    __device__ __forceinline__ void a_ready(const Unit&) const {}
    __device__ __forceinline__ void done(const Unit&) const {}
};

typedef float f32x2_c __attribute__((ext_vector_type(2))); typedef __bf16 bf16x2_c __attribute__((ext_vector_type(2)));
__device__ __forceinline__ unsigned cvt_pk_bf16(float lo, float hi) { const f32x2_c v = {lo, hi}; const bf16x2_c b = __builtin_convertvector(v, bf16x2_c); return __builtin_bit_cast(unsigned, b); }

struct EpiProj {
    static constexpr bool PERM = true, AFTER_DRAIN = false;
    bf16_t* O; int ldc; float* gates; int gate_pn; int nscale; float sc0;
    __device__ __forceinline__ void operator()(const f32x4 (&acc)[2][2][4][2], const Unit& u, int wr, int wc, int fr, int fq) const {
        const int row0 = u.pm * BM + wr * 64 + fr;
        if (u.pn == gate_pn) {
            if (wc == 0 && fq == 0) {
#pragma unroll
                for (int ai = 0; ai < 2; ++ai)
#pragma unroll
                    for (int m = 0; m < 4; ++m) { float* g = gates + (size_t)(row0 + ai * HALF + m * 16) * 8; *(f32x4*)g = acc[ai][0][m][0]; *(f32x4*)(g + 4) = acc[ai][0][m][1]; }
            }
            return;
        }
        const float sc = (u.pn < nscale) ? sc0 : 1.f;
        const int col0 = u.pn * BM + wc * 32 + 8 * fq;
#pragma unroll
        for (int ai = 0; ai < 2; ++ai)
#pragma unroll
            for (int m = 0; m < 4; ++m) { bf16_t* rowp = O + (size_t)(row0 + ai * HALF + m * 16) * ldc + col0;
#pragma unroll
                for (int bj = 0; bj < 2; ++bj) { const f32x4 v0 = acc[ai][bj][m][0] * sc, v1 = acc[ai][bj][m][1] * sc;
                    u32x4 w; w.x = cvt_pk_bf16(v0[0], v0[1]); w.y = cvt_pk_bf16(v0[2], v0[3]); w.z = cvt_pk_bf16(v1[0], v1[1]); w.w = cvt_pk_bf16(v1[2], v1[3]);
                    *(u32x4*)(rowp + bj * HALF) = w; } }
    }
};
struct EpiRelu2 {
    static constexpr bool PERM = true, AFTER_DRAIN = false;
    bf16_t* O; int ldc;
    __device__ __forceinline__ void operator()(const f32x4 (&acc)[2][2][4][2], const Unit& u, int wr, int wc, int fr, int fq) const {
        const int row0 = u.pm * BM + wr * 64 + fr, col0 = u.pn * BM + wc * 32 + 8 * fq;
#pragma unroll
        for (int ai = 0; ai < 2; ++ai)
#pragma unroll
            for (int m = 0; m < 4; ++m) { bf16_t* rowp = O + (size_t)(row0 + ai * HALF + m * 16) * ldc + col0;
#pragma unroll
                for (int bj = 0; bj < 2; ++bj) { f32x4 v0 = acc[ai][bj][m][0], v1 = acc[ai][bj][m][1];
#pragma unroll
                    for (int j = 0; j < 4; ++j) { const float a = fmaxf(v0[j], 0.f), b = fmaxf(v1[j], 0.f); v0[j] = a * a; v1[j] = b * b; }
                    u32x4 w; w.x = cvt_pk_bf16(v0[0], v0[1]); w.y = cvt_pk_bf16(v0[2], v0[3]); w.z = cvt_pk_bf16(v1[0], v1[1]); w.w = cvt_pk_bf16(v1[2], v1[3]);
                    *(u32x4*)(rowp + bj * HALF) = w; } }
    }
};
struct EpiResF32 {
    static constexpr bool PERM = false, AFTER_DRAIN = false;
    const float* res_lo; const float* res_hi; int split_pm; float* C; int ldc;
    __device__ __forceinline__ void operator()(const f32x4 (&acc)[2][2][4][2], const Unit& u, int wr, int wc, int fr, int fq) const {
        const int row0 = u.pm * BM + wr * 64 + fr, col0 = u.pn * BM + wc * 32 + 4 * fq;
        const float* rb = (u.pm < split_pm) ? res_lo : res_hi - (size_t)split_pm * BM * ldc;
#pragma unroll
        for (int ai = 0; ai < 2; ++ai)
#pragma unroll
            for (int m = 0; m < 4; ++m) { const size_t off = (size_t)(row0 + ai * HALF + m * 16) * ldc + col0;
                f32x4 o[2][2];
#pragma unroll
                for (int bj = 0; bj < 2; ++bj)
#pragma unroll
                    for (int n = 0; n < 2; ++n) o[bj][n] = *(const f32x4*)(rb + off + bj * HALF + n * 16) + acc[ai][bj][m][n];
#pragma unroll
                for (int bj = 0; bj < 2; ++bj)
#pragma unroll
                    for (int n = 0; n < 2; ++n) *(f32x4*)(C + off + bj * HALF + n * 16) = o[bj][n];
                asm volatile("" ::: "memory"); }
    }
};

struct EpiX1 {
    static constexpr bool PERM = true, AFTER_DRAIN = false;
    const float* res; const float* g; bf16_t* X1; bf16_t* XN; int ldr, ldx; float* rowssq;
    __device__ __forceinline__ void operator()(const f32x4 (&acc)[2][2][4][2], const Unit& u, int wr, int wc, int fr, int fq) const {
        const int row0 = u.pm * BM + wr * 64 + fr, col0 = u.pn * BM + wc * 32 + 8 * fq;
        f32x4 gv[2][2];
#pragma unroll
        for (int bj = 0; bj < 2; ++bj)
#pragma unroll
            for (int n = 0; n < 2; ++n) gv[bj][n] = *(const f32x4*)(g + col0 + bj * HALF + 4 * n);
#pragma unroll
        for (int ai = 0; ai < 2; ++ai)
#pragma unroll
            for (int m = 0; m < 4; ++m) { const int row = row0 + ai * HALF + m * 16; float ss = 0.f;
#pragma unroll
                for (int bj = 0; bj < 2; ++bj) { const float* rp = res + (size_t)row * ldr + col0 + bj * HALF;
                    const f32x4 v0 = *(const f32x4*)rp + acc[ai][bj][m][0], v1 = *(const f32x4*)(rp + 4) + acc[ai][bj][m][1];
                    ss += (v0[0] * v0[0] + v0[1] * v0[1]) + (v0[2] * v0[2] + v0[3] * v0[3]) + (v1[0] * v1[0] + v1[1] * v1[1]) + (v1[2] * v1[2] + v1[3] * v1[3]);
                    u32x4 w; w.x = cvt_pk_bf16(v0[0], v0[1]); w.y = cvt_pk_bf16(v0[2], v0[3]); w.z = cvt_pk_bf16(v1[0], v1[1]); w.w = cvt_pk_bf16(v1[2], v1[3]);
                    *(u32x4*)(X1 + (size_t)row * ldx + col0 + bj * HALF) = w;
                    const f32x4 n0 = v0 * gv[bj][0], n1 = v1 * gv[bj][1];
                    w.x = cvt_pk_bf16(n0[0], n0[1]); w.y = cvt_pk_bf16(n0[2], n0[3]); w.z = cvt_pk_bf16(n1[0], n1[1]); w.w = cvt_pk_bf16(n1[2], n1[3]);
                    *(u32x4*)(XN + (size_t)row * ldx + col0 + bj * HALF) = w; }
                ss += __shfl_xor(ss, 16); ss += __shfl_xor(ss, 32);
                if (fq == 0) (void)__hip_atomic_fetch_add(rowssq + row, ss, __ATOMIC_RELAXED, __HIP_MEMORY_SCOPE_AGENT);
                asm volatile("" ::: "memory"); }
    }
};
struct EpiRelu2S {
    static constexpr bool PERM = true, AFTER_DRAIN = false;
    bf16_t* O; int ldc; const float* rowssq; float inv_n, eps;
    __device__ __forceinline__ void operator()(const f32x4 (&acc)[2][2][4][2], const Unit& u, int wr, int wc, int fr, int fq) const {
        const int row0 = u.pm * BM + wr * 64 + fr, col0 = u.pn * BM + wc * 32 + 8 * fq;
#pragma unroll
        for (int ai = 0; ai < 2; ++ai)
#pragma unroll
            for (int m = 0; m < 4; ++m) { const int row = row0 + ai * HALF + m * 16; const float s2 = 1.f / (rowssq[row] * inv_n + eps); bf16_t* rowp = O + (size_t)row * ldc + col0;
#pragma unroll
                for (int bj = 0; bj < 2; ++bj) { f32x4 v0 = acc[ai][bj][m][0], v1 = acc[ai][bj][m][1];
#pragma unroll
                    for (int j = 0; j < 4; ++j) { const float a = fmaxf(v0[j], 0.f), b = fmaxf(v1[j], 0.f); v0[j] = a * a * s2; v1[j] = b * b * s2; }
                    u32x4 w; w.x = cvt_pk_bf16(v0[0], v0[1]); w.y = cvt_pk_bf16(v0[2], v0[3]); w.z = cvt_pk_bf16(v1[0], v1[1]); w.w = cvt_pk_bf16(v1[2], v1[3]);
                    *(u32x4*)(rowp + bj * HALF) = w; } }
    }
};
struct EpiX2 {
    static constexpr bool PERM = true, AFTER_DRAIN = false;
    bf16_t* X; int ldx;
    __device__ __forceinline__ void operator()(const f32x4 (&acc)[2][2][4][2], const Unit& u, int wr, int wc, int fr, int fq) const {
        const int row0 = u.pm * BM + wr * 64 + fr, col0 = u.pn * BM + wc * 32 + 8 * fq;
#pragma unroll
        for (int ai = 0; ai < 2; ++ai)
#pragma unroll
            for (int m = 0; m < 4; ++m) { bf16_t* rowp = X + (size_t)(row0 + ai * HALF + m * 16) * ldx + col0;
                u32x4 x[2];
#pragma unroll
                for (int bj = 0; bj < 2; ++bj) x[bj] = *(const u32x4*)(rowp + bj * HALF);
#pragma unroll
                for (int bj = 0; bj < 2; ++bj) { const f32x4 a0 = acc[ai][bj][m][0], a1 = acc[ai][bj][m][1]; u32x4 w;
                    w.x = cvt_pk_bf16(__uint_as_float(x[bj].x << 16) + a0[0], __uint_as_float(x[bj].x & 0xffff0000u) + a0[1]);
                    w.y = cvt_pk_bf16(__uint_as_float(x[bj].y << 16) + a0[2], __uint_as_float(x[bj].y & 0xffff0000u) + a0[3]);
                    w.z = cvt_pk_bf16(__uint_as_float(x[bj].z << 16) + a1[0], __uint_as_float(x[bj].z & 0xffff0000u) + a1[1]);
                    w.w = cvt_pk_bf16(__uint_as_float(x[bj].w << 16) + a1[2], __uint_as_float(x[bj].w & 0xffff0000u) + a1[3]);
                    *(u32x4*)(rowp + bj * HALF) = w; }
                asm volatile("" ::: "memory"); }
    }
};
struct SplitTailOrder {
    int pm0, kq_len, G, c;
    __device__ __forceinline__ bool next(int i, Unit& u) const {
        const int L = i * G + c; if (L >= 256) return false;
        const int x = L & 7, idx = L >> 3; u.pn = (x & 1) * 8 + (idx & 7); u.pm = pm0 + (idx >> 3); u.k0 = (x >> 1) * kq_len; return true; }
    __device__ __forceinline__ void a_ready(const Unit&) const {}
    __device__ __forceinline__ void done(const Unit&) const {}
};
struct EpiPartF32 {
    static constexpr bool PERM = false, AFTER_DRAIN = false;
    float* P; int ldc, pm0, kq_len; size_t qstride;
    __device__ __forceinline__ void operator()(const f32x4 (&acc)[2][2][4][2], const Unit& u, int wr, int wc, int fr, int fq) const {
        const int row0 = (u.pm - pm0) * BM + wr * 64 + fr, col0 = u.pn * BM + wc * 32 + 4 * fq; float* base = P + (size_t)(u.k0 / kq_len) * qstride;
#pragma unroll
        for (int ai = 0; ai < 2; ++ai)
#pragma unroll
            for (int m = 0; m < 4; ++m) { const size_t off = (size_t)(row0 + ai * HALF + m * 16) * ldc + col0;
#pragma unroll
                for (int bj = 0; bj < 2; ++bj)
#pragma unroll
                    for (int n = 0; n < 2; ++n) *(f32x4*)(base + off + bj * HALF + n * 16) = acc[ai][bj][m][n]; }
    }
};

struct NoFill { static constexpr bool ON = false; int fi, fend; __device__ __forceinline__ void set_wave(int) {} };
template <int DD, int DF>
struct WFill {
    static constexpr bool ON = true;
    static constexpr int NI_UP = (DD / 64) * (DF / 64), NI_DN = (DF / 64) * (DD / 64), NI = NI_UP + NI_DN;
    static constexpr int LG_UP = __builtin_ctz(DD / 64), LG_DN = __builtin_ctz(DF / 64);
    static_assert((DD / 64) == (1 << LG_UP) && (DF / 64) == (1 << LG_DN), "WFill: K extents must be 64 * 2^n");
    const float* Wup; const float* Wdn; void* WupT; void* WdnT; int fi, fend, base, cnt, rot0;
    typedef unsigned v4u_f __attribute__((ext_vector_type(4)));
    __device__ __forceinline__ void set_wave(int) {}
    __device__ __forceinline__ int rotated(int id) const { int x = id - base + rot0; x = x >= cnt ? x - cnt : x; return __builtin_amdgcn_readfirstlane(base + x); }
    __device__ __forceinline__ void issue(int id, PG8_LAS unsigned char* buf, int wid, int lane) const {
        id = rotated(id);
        const bool up = id < NI_UP; const int j = up ? id : id - NI_UP, sh = up ? LG_UP : LG_DN, nb = j >> sh, kb = j & ((1 << sh) - 1), N = up ? DF : DD;
        const char* src = (const char*)(up ? Wup : Wdn) + ((size_t)(64 * kb) * N + 64 * nb + 8 * wid) * 4;
        const unsigned lo = (unsigned)(lane >> 3) * (unsigned)(N * 4) + (unsigned)(lane & 7) * 4u;
#pragma unroll
        for (int r = 0; r < 8; ++r) __builtin_amdgcn_global_load_lds((const unsigned*)(src + (size_t)(8 * r) * N * 4 + lo), (PG8_LAS unsigned*)(buf + r * 288), 4, 0, 0);
    }
    __device__ __forceinline__ void read(float (&raw)[8], const PG8_LAS unsigned char* buf, int lane) const {
        const int n = lane >> 3, kq = lane & 7;
#pragma unroll
        for (int j = 0; j < 8; ++j) raw[j] = *(const PG8_LAS float*)(buf + kq * 288 + j * 32 + n * 4);
    }
    __device__ __forceinline__ void store(const float (&raw)[8], int id, int wid, int lane) const {
        id = rotated(id);
        const bool up = id < NI_UP; const int j = up ? id : id - NI_UP, sh = up ? LG_UP : LG_DN, nb = j >> sh, kb = j & ((1 << sh) - 1), Kd = up ? DD : DF;
        char* dst = (char*)(up ? WupT : WdnT) + ((size_t)(64 * nb + 8 * wid) * Kd + 64 * kb) * 2;
        v4u_f w; w.x = cvt_pk_bf16(raw[0], raw[1]); w.y = cvt_pk_bf16(raw[2], raw[3]); w.z = cvt_pk_bf16(raw[4], raw[5]); w.w = cvt_pk_bf16(raw[6], raw[7]);
        *(__attribute__((address_space(1))) v4u_f*)(dst + (unsigned)(lane >> 3) * (unsigned)(Kd * 2) + (unsigned)(lane & 7) * 16u) = w;
    }
};
template <class Epi, class Sched, bool ALIGN_EPI = false, bool SP2 = false, class Fill = NoFill>
__device__ __forceinline__ void gemm_phase(PG8_LAS unsigned char* lds, const Gemm g, const Sched& S, const Epi& E, Fill FL = Fill()) {
    static_assert(!Fill::ON || SP2, "the filler is written for the SP2 loop");
    PG8_LAS unsigned char* fbuf = lds + STAGE_BYTES + (__builtin_amdgcn_readfirstlane(threadIdx.x >> 6)) * 2304;
    const int tid = threadIdx.x, wid = __builtin_amdgcn_readfirstlane(tid >> 6), lane = tid & 63, wr = wid >> 2, wc = wid & 3, fr = lane & 15, fq = lane >> 4;
    const int K = g.ld, nt = g.K / BK;
    unsigned voffA[2], voffB[2];
#pragma unroll
    for (int i = 0; i < 2; ++i) { int R, C; stage_rc(tid * 16 + i * 8192, R, C); const int Rb = Epi::PERM ? ((R & ~31) + perm32(R & 31)) : R;
        voffA[i] = (unsigned)(R * K + C) * 2u; voffB[i] = (unsigned)(Rb * K + C) * 2u; }
    const size_t kstep = (size_t)(BK * 2);
    const size_t hstep = (size_t)HALF * K * 2;
    const size_t tstep = 2 * hstep;
    const unsigned ldsw = (unsigned)wid * 1024u;
    const int aoff = lds_byte(wr * 64 + fr, fq * 8), boff = lds_byte(wc * 32 + fr, fq * 8);
#define PG8_SA(b, h) (((b) * 2 + (h)) * HTB)
#define PG8_SB(b, h) ((4 + (b) * 2 + (h)) * HTB)
#define PG8_STAGE(bufoff, gbase, voff) do { _Pragma("unroll") for (int _i = 0; _i < 2; ++_i) \
        __builtin_amdgcn_global_load_lds((const unsigned*)((const char*)(gbase) + (voff)[_i]), (PG8_LAS unsigned*)(lds + (bufoff) + ldsw + _i * 8192), 16, 0, 0); } while (0)
#define PG8_LDA(dst, b, h) do { _Pragma("unroll") for (int m = 0; m < 4; ++m) _Pragma("unroll") for (int k = 0; k < 2; ++k) dst[m][k] = *(const PG8_LAS bf16x8*)(lds + PG8_SA(b, h) + aoff + m * 2048 + k * 1024); } while (0)
#define PG8_LDB(dst, b, h) do { _Pragma("unroll") for (int n = 0; n < 2; ++n) _Pragma("unroll") for (int k = 0; k < 2; ++k) dst[n][k] = *(const PG8_LAS bf16x8*)(lds + PG8_SB(b, h) + boff + n * 2048 + k * 1024); } while (0)
#define PG8_MMA(ai, bj, At, Bt) do { __builtin_amdgcn_s_setprio(1); _Pragma("unroll") for (int m = 0; m < 4; ++m) _Pragma("unroll") for (int n = 0; n < 2; ++n) _Pragma("unroll") for (int k = 0; k < 2; ++k) \
        acc[ai][bj][m][n] = __builtin_amdgcn_mfma_f32_16x16x32_bf16(Bt[n][k], At[m][k], acc[ai][bj][m][n], 0, 0, 0); __builtin_amdgcn_s_setprio(0); } while (0)
#define PG8_WAIT_V(n) asm volatile("s_waitcnt vmcnt(" #n ")" ::: "memory")
#define PG8_WAIT_L(n) asm volatile("s_waitcnt lgkmcnt(" #n ")" ::: "memory")
#define PG8_BAR __builtin_amdgcn_s_barrier()
#define PG8_SCHED __builtin_amdgcn_sched_barrier(0)
    Unit cur, nxt; int ui = 0;
    if constexpr (Fill::ON) { FL.set_wave(wid); if (FL.fi < FL.fend) FL.issue(FL.fi, fbuf, wid, lane); }
    if (S.next(0, cur)) {
    f32x4 acc[2][2][4][2];
#pragma unroll
    for (int a = 0; a < 2; ++a)
#pragma unroll
        for (int b = 0; b < 2; ++b)
#pragma unroll
            for (int m = 0; m < 4; ++m)
#pragma unroll
                for (int n = 0; n < 2; ++n) acc[a][b][m][n] = (f32x4){0.f, 0.f, 0.f, 0.f};
    bf16x8 At[4][2], B0[2][2], B1[2][2];
    const char* cA = (const char*)g.A + (size_t)cur.pm * tstep + (size_t)cur.k0 * 2; const char* cB = (const char*)g.Bt + (size_t)cur.pn * tstep + (size_t)cur.k0 * 2;
    S.a_ready(cur);
    if constexpr (SP2) {
        PG8_STAGE(PG8_SB(0, 0), cB, voffB); PG8_STAGE(PG8_SB(0, 1), cB + hstep, voffB); PG8_STAGE(PG8_SA(0, 0), cA, voffA); PG8_STAGE(PG8_SA(0, 1), cA + hstep, voffA);
        if (wr == 1) PG8_BAR;
        PG8_WAIT_V(2); PG8_BAR;
        PG8_STAGE(PG8_SB(1, 0), cB + kstep, voffB); PG8_STAGE(PG8_SA(1, 0), cA + kstep, voffA); PG8_STAGE(PG8_SB(1, 1), cB + hstep + kstep, voffB);
        PG8_WAIT_V(6); PG8_BAR;
    } else {
        PG8_STAGE(PG8_SB(0, 0), cB, voffB); PG8_STAGE(PG8_SA(0, 0), cA, voffA); PG8_STAGE(PG8_SB(0, 1), cB + hstep, voffB); PG8_STAGE(PG8_SA(0, 1), cA + hstep, voffA);
        if (wr == 1) PG8_BAR;
        PG8_WAIT_V(4); PG8_BAR;
        PG8_STAGE(PG8_SB(1, 0), cB + kstep, voffB); PG8_STAGE(PG8_SA(1, 0), cA + kstep, voffA); PG8_STAGE(PG8_SB(1, 1), cB + hstep + kstep, voffB);
        PG8_WAIT_V(6); PG8_BAR;
    }
    for (;;) {
        const bool has_next = S.next(ui + 1, nxt);
        const char* nA = has_next ? (const char*)g.A + (size_t)nxt.pm * tstep + (size_t)nxt.k0 * 2 : cA; const char* nB = has_next ? (const char*)g.Bt + (size_t)nxt.pn * tstep + (size_t)nxt.k0 * 2 : cB;
        for (int t = 0; t < nt; t += 2) {
            const bool last = (t == nt - 2);
            const char* a1 = cA + (size_t)(t + 1) * kstep;
            const char* a2 = last ? nA : cA + (size_t)(t + 2) * kstep; const char* b2 = last ? nB : cB + (size_t)(t + 2) * kstep;
            const char* a3 = a2 + kstep; const char* b3 = b2 + kstep;
            if (last && has_next) S.a_ready(nxt);
            if constexpr (SP2) {
            bool fact = false; float fraw[8];
            if constexpr (Fill::ON) { fact = FL.fi < FL.fend; if (fact) { FL.read(fraw, fbuf, lane); PG8_SCHED; } }
            PG8_LDB(B0, 0, 0); PG8_LDB(B1, 0, 1); PG8_SCHED; PG8_LDA(At, 0, 0); PG8_STAGE(PG8_SA(1, 1), a1 + hstep, voffA);
            if constexpr (Fill::ON) { if (fact) { PG8_SCHED; FL.store(fraw, FL.fi, wid, lane); asm volatile("" ::: "memory");
                    const int nf = FL.fi + 1 < FL.fend ? FL.fi + 1 : FL.fi; FL.issue(nf, fbuf, wid, lane); FL.fi += 1; PG8_SCHED; } }
            if (fact) PG8_WAIT_V(17); else PG8_WAIT_V(8);
            PG8_WAIT_L(0); PG8_BAR; PG8_MMA(0, 0, At, B0); PG8_MMA(0, 1, At, B1); PG8_BAR; PG8_SCHED;
            PG8_LDA(At, 0, 1); PG8_STAGE(PG8_SB(0, 0), b2, voffB); PG8_STAGE(PG8_SB(0, 1), b2 + hstep, voffB); PG8_STAGE(PG8_SA(0, 0), a2, voffA);
            if (fact) PG8_WAIT_V(17); else PG8_WAIT_V(8);
            PG8_WAIT_L(0); PG8_BAR; PG8_MMA(1, 0, At, B0); PG8_MMA(1, 1, At, B1); PG8_BAR; PG8_SCHED;
            PG8_LDB(B0, 1, 0); PG8_LDB(B1, 1, 1); PG8_SCHED; PG8_LDA(At, 1, 0); PG8_STAGE(PG8_SA(0, 1), a2 + hstep, voffA);
            if (fact) PG8_WAIT_V(17); else PG8_WAIT_V(8);
            PG8_WAIT_L(0); PG8_BAR; PG8_MMA(0, 0, At, B0); PG8_MMA(0, 1, At, B1); PG8_BAR; PG8_SCHED;
            PG8_LDA(At, 1, 1); PG8_STAGE(PG8_SB(1, 0), b3, voffB); PG8_STAGE(PG8_SB(1, 1), b3 + hstep, voffB); PG8_STAGE(PG8_SA(1, 0), a3, voffA);
            PG8_WAIT_V(8); PG8_WAIT_L(0); PG8_BAR; PG8_MMA(1, 0, At, B0); PG8_MMA(1, 1, At, B1); PG8_BAR; PG8_SCHED;
            } else {
            PG8_LDB(B0, 0, 0); PG8_SCHED; PG8_LDA(At, 0, 0); PG8_STAGE(PG8_SA(1, 1), a1 + hstep, voffA);
            PG8_WAIT_L(8); PG8_BAR; PG8_WAIT_L(0); PG8_MMA(0, 0, At, B0); PG8_BAR; PG8_SCHED;
            PG8_LDB(B1, 0, 1); PG8_STAGE(PG8_SB(0, 0), b2, voffB);
            PG8_BAR; PG8_WAIT_L(0); PG8_MMA(0, 1, At, B1); PG8_BAR;
            PG8_LDA(At, 0, 1); PG8_STAGE(PG8_SA(0, 0), a2, voffA);
            PG8_BAR; PG8_WAIT_L(0); PG8_MMA(1, 0, At, B0); PG8_BAR; PG8_SCHED;
            PG8_STAGE(PG8_SB(0, 1), b2 + hstep, voffB);
            PG8_WAIT_V(6); PG8_BAR; PG8_MMA(1, 1, At, B1); PG8_BAR;
            PG8_LDB(B0, 1, 0); PG8_SCHED; PG8_LDA(At, 1, 0); PG8_STAGE(PG8_SA(0, 1), a2 + hstep, voffA);
            PG8_WAIT_L(8); PG8_BAR; PG8_WAIT_L(0); PG8_MMA(0, 0, At, B0); PG8_BAR; PG8_SCHED;
            PG8_LDB(B1, 1, 1); PG8_STAGE(PG8_SB(1, 0), b3, voffB);
            PG8_BAR; PG8_WAIT_L(0); PG8_MMA(0, 1, At, B1); PG8_BAR;
            PG8_LDA(At, 1, 1); PG8_STAGE(PG8_SA(1, 0), a3, voffA);
            PG8_BAR; PG8_WAIT_L(0); PG8_MMA(1, 0, At, B0); PG8_BAR; PG8_SCHED;
            PG8_STAGE(PG8_SB(1, 1), b3 + hstep, voffB);
            PG8_WAIT_V(6); PG8_BAR; PG8_MMA(1, 1, At, B1); PG8_BAR;
            }
        }
        if constexpr (ALIGN_EPI) { if (wr == 0) PG8_BAR; }
        if constexpr (!Epi::AFTER_DRAIN) { E(acc, cur, wr, wc, fr, fq); S.done(cur); }
        if (!has_next) break;
#pragma unroll
        for (int a = 0; a < 2; ++a)
#pragma unroll
            for (int b = 0; b < 2; ++b)
#pragma unroll
                for (int m = 0; m < 4; ++m)
#pragma unroll
                    for (int n = 0; n < 2; ++n) acc[a][b][m][n] = (f32x4){0.f, 0.f, 0.f, 0.f};
        cur = nxt; cA = nA; cB = nB; ++ui;
        if constexpr (ALIGN_EPI) { if (wr == 1) PG8_BAR; }
    }
    PG8_WAIT_V(0);
    if constexpr (!ALIGN_EPI) { if (wr == 0) PG8_BAR; }
    PG8_BAR;
    if constexpr (Epi::AFTER_DRAIN) { E.fused(acc, cur, wr, wc, fr, fq, lds, wid, lane); S.done(cur); }
    }
    if constexpr (Fill::ON) {
        while (FL.fi < FL.fend) { float fraw[8]; PG8_WAIT_V(0); FL.read(fraw, fbuf, lane); FL.store(fraw, FL.fi, wid, lane); PG8_WAIT_L(0); asm volatile("" ::: "memory");
            FL.fi += 1; if (FL.fi < FL.fend) FL.issue(FL.fi, fbuf, wid, lane); }
        PG8_WAIT_V(0);
    }
#undef PG8_SA
#undef PG8_SB
#undef PG8_STAGE
#undef PG8_LDA
#undef PG8_LDB
#undef PG8_MMA
#undef PG8_WAIT_V
#undef PG8_WAIT_L
#undef PG8_BAR
#undef PG8_SCHED
}
}

constexpr int NWAVES = 8;
#ifndef MK_N_LAUNCHES
#define MK_N_LAUNCHES 1
#endif
#ifndef PROBE_REPEAT
#define PROBE_REPEAT -1
#endif
constexpr int N_LAUNCHES = MK_N_LAUNCHES;
constexpr int N_PHASES = 9;
static_assert(N_LAUNCHES == 1 || N_LAUNCHES == N_PHASES, "MK_N_LAUNCHES is 1 or 9");
#ifndef MIX_SLOW_GATHER
#define MIX_SLOW_GATHER 0
#endif

constexpr int D = 4096, MP = 8192, MS = 1024, M = MP + MS, NPROJ = 12288, NPROJ_PAD = 12544, IN_COLS = 12296, FF = 16384;
constexpr int SEQ = 2048, NB = 4, DECB = 128, DECT = 8, PAST = 16384;
constexpr int HM = 4, DKM = 256, DVM = 512, HR = 8, DKR = 128, DVR = 256;
constexpr float RMS_EPS = 1e-6f, SOFTCAP = 15.f;
constexpr int PC_QM = 0, PC_KM = 1024, PC_VM = 2048, PC_OM = 4096, PC_QR = 6144, PC_KR = 7168, PC_VR = 8192, PC_GR = 10240;
constexpr size_t O_Y = 0, O_PC = 37748736, O_PN = 39845888, O_PM = 39849984, O_PS = 39850000, O_SC = 40898576, O_SN = 108007440, O_SM = 108138512, O_SS = 108139024, O_END = 141693456;
constexpr size_t MiB = 1u << 20;
constexpr size_t WS_CTL = 0, CTL_ZERO_BYTES = 1 * MiB;
constexpr size_t WS_WIN = 2 * MiB, WS_WOUT = 100 * MiB, WS_WUP = 132 * MiB, WS_WDN = 260 * MiB;
constexpr size_t WS_XN = 388 * MiB;
constexpr size_t WS_PROJ = 460 * MiB;
constexpr size_t WS_GATES = 676 * MiB;
constexpr size_t WS_SSQ = 677 * MiB;
constexpr size_t WS_ROPE = 682 * MiB;
constexpr size_t WS_HRAW = 684 * MiB;
constexpr size_t WS_X1B = WS_HRAW;
constexpr size_t WS_CAT = 756 * MiB;
constexpr size_t WS_U = 828 * MiB;
constexpr size_t WS_PART = 1116 * MiB;
constexpr size_t WS_END = 1180 * MiB;
static_assert(WS_WIN + (size_t)NPROJ_PAD * D * 2 <= WS_WOUT && WS_WOUT + (size_t)D * D * 2 <= WS_WUP && WS_WUP + (size_t)FF * D * 2 <= WS_WDN && WS_WDN + (size_t)FF * D * 2 <= WS_XN, "ws map 1");
static_assert(WS_XN + (size_t)M * D * 2 <= WS_PROJ && WS_PROJ + (size_t)M * NPROJ * 2 <= WS_GATES && WS_GATES + (size_t)M * 8 * 4 <= WS_SSQ && WS_SSQ + (size_t)M * 128 * 4 <= WS_ROPE, "ws map 2");
static_assert(WS_ROPE + (size_t)2056 * 64 * 8 <= WS_HRAW && WS_HRAW + (size_t)M * D * 2 <= WS_CAT && WS_CAT + (size_t)M * D * 2 <= WS_U && WS_U + (size_t)M * FF * 2 <= WS_PART && WS_PART + (size_t)4 * MS * D * 4 <= WS_END, "ws map 3");
constexpr int CW_TMO = 0, CW_CODE = 1;
constexpr int CW_BAR = 4096;
constexpr int CW_ROWSSQ = 16384;
constexpr int CW_QUEUE = 8192;
constexpr int LDS_BYTES = 163840;
constexpr int LDSCTL_OFF = 162816, MISC_OFF = LDSCTL_OFF + 320;
static_assert(MISC_OFF + 128 <= LDS_BYTES, "LDS map");

#define GAS __attribute__((address_space(1)))
#define LAS __attribute__((address_space(3)))
typedef unsigned short bf16;
typedef unsigned v4u __attribute__((ext_vector_type(4)));
typedef unsigned v2u __attribute__((ext_vector_type(2)));
typedef float f32x4 __attribute__((ext_vector_type(4)));
typedef float f32x2 __attribute__((ext_vector_type(2)));
typedef short bf16x8 __attribute__((ext_vector_type(8)));
typedef short s16x4 __attribute__((ext_vector_type(4)));
typedef GAS unsigned gu32;
#define RLX_AGENT __ATOMIC_RELAXED, __HIP_MEMORY_SCOPE_AGENT
#define LDS_WAIT() asm volatile("s_waitcnt lgkmcnt(0)" ::: "memory")
#define VM_WAIT() asm volatile("s_waitcnt vmcnt(0)" ::: "memory")
typedef float f32x2_t __attribute__((ext_vector_type(2))); typedef __bf16 bf16x2_t __attribute__((ext_vector_type(2)));
__device__ __forceinline__ unsigned pk2(float lo, float hi) { const f32x2_t v = {lo, hi}; const bf16x2_t b = __builtin_convertvector(v, bf16x2_t); return __builtin_bit_cast(unsigned, b); }
__device__ __forceinline__ float bf_lo(unsigned w) { return __uint_as_float(w << 16); }
__device__ __forceinline__ float bf_hi(unsigned w) { return __uint_as_float(w & 0xffff0000u); }

#define XB_TMO      128
#define XB_XCNT(j)  (256  + 64 * (j))
#define XB_XSUB(j)  (1280 + 64 * (j))
#define XB_XGEN(j)  (2304 + 64 * (j))
#define XB_TOP      3328
#define XB_TOPGEN   3392
#define XCD_BAR_WORDS 3456
#define XB_SPIN_CAP (1u << 18)

__device__ __forceinline__ unsigned xb_ld(unsigned* p)              { return __hip_atomic_load(p, __ATOMIC_RELAXED, __HIP_MEMORY_SCOPE_AGENT); }
__device__ __forceinline__ unsigned xb_add(unsigned* p, unsigned v) { return __hip_atomic_fetch_add(p, v, __ATOMIC_RELAXED, __HIP_MEMORY_SCOPE_AGENT); }
__device__ __forceinline__ unsigned xb_xcc_id() { return (unsigned)__builtin_amdgcn_s_getreg((3 << 11) | 20) & 0xFu; }
#define XB_SPIN(cond, bar) do { unsigned _sp = 0; while (cond) { __builtin_amdgcn_s_sleep(1); \
    if ((++_sp & 255u) == 0u) { if (xb_ld(&(bar)[XB_TMO])) break; if (_sp > XB_SPIN_CAP) { atomicAdd(&(bar)[XB_TMO], 1u); break; } } } } while (0)

struct XcdBarrier {
    unsigned* bar; unsigned x;
    volatile LAS unsigned* st;
};

__device__ __forceinline__ XcdBarrier xcd_barrier_post(unsigned* bar, volatile LAS unsigned* st) {
    XcdBarrier b; b.bar = bar; b.x = xb_xcc_id(); b.st = st;
    if (threadIdx.x == 0) (void)xb_add(&bar[XB_XCNT(b.x)], 1u);
    return b;
}
__device__ __forceinline__ void xcd_barrier_complete(unsigned* bar, unsigned x, unsigned& nloc, unsigned& nx) {
    const unsigned G = gridDim.x * gridDim.y * gridDim.z;
    unsigned sum, cnt, mine, sp = 0u;
    for (;;) {
        sum = 0u; cnt = 0u; mine = 0u;
#pragma unroll
        for (unsigned j = 0; j < 16; ++j) { const unsigned c = xb_ld(&bar[XB_XCNT(j)]); sum += c; cnt += (c > 0u) ? 1u : 0u; mine = (j == x) ? c : mine; }
        if (sum == G) break;
        __builtin_amdgcn_s_sleep(1);
        if ((++sp & 255u) == 0u) { if (xb_ld(&bar[XB_TMO])) break; if (sp > XB_SPIN_CAP) { atomicAdd(&bar[XB_TMO], 1u); break; } }
    }
    nloc = mine > 0u ? mine : 1u; nx = cnt > 0u ? cnt : 1u;
}

__device__ __forceinline__ void xcd_barrier(const XcdBarrier& b) {
    asm volatile("s_waitcnt vmcnt(0)" ::: "memory");
    __syncthreads();
    if (threadIdx.x == 0) {
        unsigned* bar = b.bar;
        __builtin_amdgcn_s_waitcnt(0);
        unsigned nloc = b.st[0], nx = b.st[1];
        if (nloc == 0u) { xcd_barrier_complete(bar, b.x, nloc, nx); b.st[0] = nloc; b.st[1] = nx; }
        const unsigned old = xb_add(&bar[XB_XSUB(b.x)], 1u);
        const unsigned gen = old / nloc;
        if (old + 1u == (gen + 1u) * nloc) {
            __builtin_amdgcn_fence(__ATOMIC_RELEASE, "agent");
            asm volatile("s_waitcnt vmcnt(0)" ::: "memory");
            const unsigned og = xb_add(&bar[XB_TOP], 1u);
            const unsigned tg = og / nx;
            if (og + 1u == (tg + 1u) * nx) xb_add(&bar[XB_TOPGEN], 1u);
            else XB_SPIN(xb_ld(&bar[XB_TOPGEN]) == tg, bar);
            __builtin_amdgcn_fence(__ATOMIC_ACQUIRE, "agent");
            xb_add(&bar[XB_XGEN(b.x)], 1u);
            asm volatile("s_waitcnt vmcnt(0)" ::: "memory");
        } else {
            XB_SPIN(xb_ld(&bar[XB_XGEN(b.x)]) == gen, bar);
            __builtin_amdgcn_fence(__ATOMIC_ACQUIRE, "agent");
            asm volatile("s_waitcnt vmcnt(0)" ::: "memory");
        }
    }
    __syncthreads();
}

struct Frame {
    LAS unsigned char* lds;
    volatile LAS unsigned* MISC;
    gu32* ctl;
    int tid, lane, wave;
    int vcu, G;
    const float* in[17]; float* out; unsigned char* ws;
};
__device__ __forceinline__ float wave_sum(float v) {
#pragma unroll
    for (int o = 1; o < 64; o <<= 1) v += __shfl_xor(v, o);
    return v;
}
__device__ __forceinline__ const float* x_row(const Frame& F, int m) { return m < MP ? F.in[0] + (size_t)m * D : F.in[1] + (size_t)(m - MP) * D; }

__device__ __forceinline__ void p0_transpose_item(const float* W, int ldw, int K, int k0, int src_col0, bf16* WT, int dst_row0, LAS float* scr, int lane) {
#pragma unroll 8
    for (int i = 0; i < 32; ++i) { const int kk = 2 * i + (lane >> 5); scr[kk * 33 + (lane & 31)] = W[(size_t)(k0 + kk) * ldw + src_col0 + (lane & 31)]; }
    LDS_WAIT(); asm volatile("" ::: "memory");
    const int c = lane & 7;
#pragma unroll
    for (int j = 0; j < 4; ++j) { const int n = (lane >> 3) + 8 * j; const LAS float* s = scr + (8 * c) * 33 + n;
        v4u o; o.x = pk2(s[0 * 33], s[1 * 33]); o.y = pk2(s[2 * 33], s[3 * 33]); o.z = pk2(s[4 * 33], s[5 * 33]); o.w = pk2(s[6 * 33], s[7 * 33]);
        *(GAS v4u*)(WT + (size_t)(dst_row0 + n) * K + k0 + 8 * c) = o; }
    LDS_WAIT(); asm volatile("" ::: "memory");
}
template <bool OUT_BF16>
__device__ __forceinline__ void rms_row(const float* xrow, const float* g, void* orow, int lane) {
    const GAS f32x4* xr = (const GAS f32x4*)xrow + lane; const GAS f32x4* gr = (const GAS f32x4*)g + lane;
    f32x4 v[16]; float s = 0.f;
#pragma unroll
    for (int j = 0; j < 16; ++j) { v[j] = xr[64 * j]; s += (v[j].x * v[j].x + v[j].y * v[j].y) + (v[j].z * v[j].z + v[j].w * v[j].w); }
    const float rstd = 1.f / sqrtf(wave_sum(s) * (1.f / D) + RMS_EPS);
#pragma unroll
    for (int j = 0; j < 16; ++j) { const f32x4 o = v[j] * rstd * gr[64 * j];
        if (OUT_BF16) { v2u w; w.x = pk2(o.x, o.y); w.y = pk2(o.z, o.w); ((GAS v2u*)orow)[lane + 64 * j] = w; }
        else ((GAS f32x4*)orow)[lane + 64 * j] = o; }
}
template <bool OUT_BF16>
__device__ __forceinline__ void rms_row_sum(const float* base, const float* part, size_t qstride, float* xsum, const float* g, void* orow, int lane) {
    const GAS f32x4* xr = (const GAS f32x4*)base + lane; const GAS f32x4* pr = (const GAS f32x4*)part + lane; const GAS f32x4* gr = (const GAS f32x4*)g + lane; const size_t q4 = qstride / 4;
    f32x4 v[16]; float s = 0.f;
#pragma unroll
    for (int j = 0; j < 16; ++j) { v[j] = xr[64 * j] + ((pr[64 * j] + pr[q4 + 64 * j]) + (pr[2 * q4 + 64 * j] + pr[3 * q4 + 64 * j])); s += (v[j].x * v[j].x + v[j].y * v[j].y) + (v[j].z * v[j].z + v[j].w * v[j].w); }
    if (xsum) {
#pragma unroll
        for (int j = 0; j < 16; ++j) ((GAS f32x4*)xsum)[lane + 64 * j] = v[j]; }
    const float rstd = 1.f / sqrtf(wave_sum(s) * (1.f / D) + RMS_EPS);
#pragma unroll
    for (int j = 0; j < 16; ++j) { const f32x4 o = v[j] * rstd * gr[64 * j];
        if (OUT_BF16) { v2u w; w.x = pk2(o.x, o.y); w.y = pk2(o.z, o.w); ((GAS v2u*)orow)[lane + 64 * j] = w; }
        else ((GAS f32x4*)orow)[lane + 64 * j] = o; }
}
__device__ __forceinline__ void x1_sample_row(const float* x, const float* part, size_t qstride, const float* g, bf16* x1b, bf16* xn, float* ssq_out, int lane) {
    float s = 0.f;
#pragma unroll
    for (int j = 0; j < 8; ++j) { const int c = lane + 64 * j; f32x4 v0 = *(const GAS f32x4*)(x + 8 * c), v1 = *(const GAS f32x4*)(x + 8 * c + 4);
#pragma unroll
        for (int q = 0; q < 4; ++q) { v0 += *(const GAS f32x4*)(part + q * qstride + 8 * c); v1 += *(const GAS f32x4*)(part + q * qstride + 8 * c + 4); }
        s += (v0.x * v0.x + v0.y * v0.y) + (v0.z * v0.z + v0.w * v0.w) + (v1.x * v1.x + v1.y * v1.y) + (v1.z * v1.z + v1.w * v1.w);
        v4u w; w.x = pk2(v0.x, v0.y); w.y = pk2(v0.z, v0.w); w.z = pk2(v1.x, v1.y); w.w = pk2(v1.z, v1.w); ((GAS v4u*)x1b)[c] = w;
        const f32x4 g0 = *(const GAS f32x4*)(g + 8 * c), g1 = *(const GAS f32x4*)(g + 8 * c + 4); v0 = v0 * g0; v1 = v1 * g1;
        w.x = pk2(v0.x, v0.y); w.y = pk2(v0.z, v0.w); w.z = pk2(v1.x, v1.y); w.w = pk2(v1.z, v1.w); ((GAS v4u*)xn)[c] = w; }
    s = wave_sum(s);
    if (lane == 0) *ssq_out = s;
}
template <bool PART>
__device__ __forceinline__ void final_row(const bf16* xb, const float* part, size_t qstride, const float* g, float* y, int lane) {
    f32x4 v[8][2]; float s = 0.f;
#pragma unroll
    for (int j = 0; j < 8; ++j) { const int c = lane + 64 * j; const v4u w = ((const GAS v4u*)xb)[c];
        v[j][0] = (f32x4){bf_lo(w.x), bf_hi(w.x), bf_lo(w.y), bf_hi(w.y)}; v[j][1] = (f32x4){bf_lo(w.z), bf_hi(w.z), bf_lo(w.w), bf_hi(w.w)};
        if (PART) {
#pragma unroll
            for (int q = 0; q < 4; ++q) { v[j][0] += *(const GAS f32x4*)(part + q * qstride + 8 * c); v[j][1] += *(const GAS f32x4*)(part + q * qstride + 8 * c + 4); } }
        s += (v[j][0].x * v[j][0].x + v[j][0].y * v[j][0].y) + (v[j][0].z * v[j][0].z + v[j][0].w * v[j][0].w) + (v[j][1].x * v[j][1].x + v[j][1].y * v[j][1].y) + (v[j][1].z * v[j][1].z + v[j][1].w * v[j][1].w); }
    const float rstd = 1.f / sqrtf(wave_sum(s) * (1.f / D) + RMS_EPS);
#pragma unroll
    for (int j = 0; j < 8; ++j) { const int c = lane + 64 * j;
        *(GAS f32x4*)(y + 8 * c) = v[j][0] * rstd * *(const GAS f32x4*)(g + 8 * c); *(GAS f32x4*)(y + 8 * c + 4) = v[j][1] * rstd * *(const GAS f32x4*)(g + 8 * c + 4); }
}
__device__ __forceinline__ void frow_load(v2u (&xw)[16], const bf16* xb, int lane) {
#pragma unroll
    for (int j = 0; j < 16; ++j) xw[j] = ((const GAS v2u*)xb)[lane + 64 * j];
}
template <bool PART>
__device__ __forceinline__ void frow_finish(const v2u (&xw)[16], const float* part, size_t qstride, const float* g, float* y, int lane) {
    f32x4 v[16]; float s = 0.f;
#pragma unroll
    for (int j = 0; j < 16; ++j) { v[j] = (f32x4){bf_lo(xw[j].x), bf_hi(xw[j].x), bf_lo(xw[j].y), bf_hi(xw[j].y)};
        if (PART) { const GAS f32x4* p = (const GAS f32x4*)part + lane + 64 * j; const size_t q4 = qstride / 4; v[j] += (p[0] + p[q4]) + (p[2 * q4] + p[3 * q4]); if ((j & 3) == 3) asm volatile("" ::: "memory"); }
        s += (v[j].x * v[j].x + v[j].y * v[j].y) + (v[j].z * v[j].z + v[j].w * v[j].w); }
    const float rstd = 1.f / sqrtf(wave_sum(s) * (1.f / D) + RMS_EPS);
#pragma unroll
    for (int j = 0; j < 16; ++j) { ((GAS f32x4*)y)[lane + 64 * j] = v[j] * rstd * ((const GAS f32x4*)g)[lane + 64 * j]; if ((j & 3) == 3) asm volatile("" ::: "memory"); }
}
__device__ __forceinline__ void sincos_d(float a, float& c, float& s) {
    const double x = (double)a; const double n = rint(x * 0.63661977236758134308);
    double r = fma(-n, 1.57079632679489655800e+00, x); r = fma(-n, 6.12323399573676603587e-17, r);
    const double r2 = r * r;
    double sp = -7.6471637318198164759e-13; sp = fma(sp, r2, 1.6059043836821614599e-10); sp = fma(sp, r2, -2.5052108385441718775e-08); sp = fma(sp, r2, 2.7557319223985890653e-06);
    sp = fma(sp, r2, -1.9841269841269841270e-04); sp = fma(sp, r2, 8.3333333333333333333e-03); sp = fma(sp, r2, -1.6666666666666666667e-01); const double sn = fma(sp * r2, r, r);
    double cp = 4.7794773323873852974e-14; cp = fma(cp, r2, -1.1470745597729724714e-11); cp = fma(cp, r2, 2.0876756987868098979e-09); cp = fma(cp, r2, -2.7557319223985890653e-07);
    cp = fma(cp, r2, 2.4801587301587301587e-05); cp = fma(cp, r2, -1.3888888888888888889e-03); cp = fma(cp, r2, 4.1666666666666666667e-02); cp = fma(cp, r2, -0.5); const double cs = fma(cp, r2, 1.0);
    const int q = (int)n & 3;
    const double ss = (q & 1) ? cs : sn, cc = (q & 1) ? sn : cs;
    s = (float)((q & 2) ? -ss : ss); c = (float)(((q + 1) & 2) ? -cc : cc);
}
__device__ __forceinline__ void p0_prologue(Frame& F) {
    LAS float* scr = (LAS float*)(F.lds + F.wave * 16384);
    const int gw = F.vcu * NWAVES + F.wave, NGW = F.G * NWAVES;
    const float* Win = F.in[6]; const float* Wout = F.in[11]; const float* Wup = F.in[14]; const float* Wdn = F.in[15];
    bf16* WinT = (bf16*)(F.ws + WS_WIN); bf16* WoutT = (bf16*)(F.ws + WS_WOUT); bf16* WupT = (bf16*)(F.ws + WS_WUP); bf16* WdnT = (bf16*)(F.ws + WS_WDN);
    constexpr int I_IN = (D / 64) * (NPROJ / 32), I_OUT = (D / 64) * (D / 32), I_UP = (D / 64) * (FF / 32), I_DN = (FF / 64) * (D / 32);
    constexpr int NITEMS = I_IN + I_OUT;
    for (int it = gw; it < NITEMS; it += NGW) {
        int r = NITEMS - 1 - it;
        if (r < I_IN) { const int nblk = NPROJ / 32, kb = r / nblk, nb = r % nblk, n0 = 32 * nb; p0_transpose_item(Win, IN_COLS, D, 64 * kb, n0 < 6144 ? n0 : n0 + 8, WinT, n0, scr, F.lane); continue; } r -= I_IN;
        { const int nblk = D / 32, kb = r / nblk, nb = r % nblk; p0_transpose_item(Wout, D, D, 64 * kb, 32 * nb, WoutT, 32 * nb, scr, F.lane); }
    }
    { const int gt = (F.vcu * NWAVES + F.wave) * 64 + F.lane, NGT = F.G * NWAVES * 64;
      for (int i = gt; i < 8 * D; i += NGT) { const int n = i / D, k = i % D; WinT[(size_t)(NPROJ + n) * D + k] = (bf16)(pk2(Win[(size_t)k * IN_COLS + 6144 + n], 0.f) & 0xffffu); }
      GAS v4u* z = (GAS v4u*)(WinT + (size_t)(NPROJ + 8) * D); const int nz = (NPROJ_PAD - NPROJ - 8) * D / 8;
      for (int i = gt; i < nz; i += NGT) z[i] = (v4u){0u, 0u, 0u, 0u};
      GAS f32x2* rope = (GAS f32x2*)(F.ws + WS_ROPE);
      for (int i = gt; i < 2056 * 64; i += NGT) { const int pi = i >> 6, j = i & 63; const float pos = (float)(pi < 2048 ? pi : PAST + pi - 2048);
          double fd = 1.0; if (j & 1) fd *= 0.8659643233600653; if (j & 2) fd *= 0.7498942093324559; if (j & 4) fd *= 0.5623413251903491; if (j & 8) fd *= 0.31622776601683794; if (j & 16) fd *= 0.1; if (j & 32) fd *= 0.01;
          const float freq = (float)fd; const float ang = pos * freq; float c, s; sincos_d(ang, c, s); rope[i] = (f32x2){c, s}; }
    }
    bf16* XN = (bf16*)(F.ws + WS_XN);
    for (int m = gw; m < M; m += NGW) rms_row<true>(x_row(F, m), F.in[12], XN + (size_t)m * D, F.lane);
}

__device__ __forceinline__ bf16x8 lds_row8(const LAS bf16* p) { return *(const LAS bf16x8*)p; }
template <int PERM> __device__ __forceinline__ int prow(int r) { return PERM == 1 ? ((r & ~12) | ((r & 4) << 1) | ((r & 8) >> 1)) : PERM == 2 ? ((r & ~7) | ((r & 3) << 1) | ((r >> 2) & 1)) : r; }
template <int PERM>
__device__ __forceinline__ bf16x8 lds_tr8(const LAS bf16* img, int stride, int k0, int c0, int fr, int fq) {
    typedef short v4i16_t __attribute__((ext_vector_type(4)));
    const int q = fr >> 2, p = fr & 3;
    const int rlo = PERM == 1 ? 16 * (fq >> 1) + 4 * (fq & 1) + q : PERM == 2 ? 8 * fq + 2 * q : 8 * fq + q;
    constexpr int dhi = PERM == 1 ? 8 : PERM == 2 ? 1 : 4;
    const LAS bf16* a = img + (k0 + rlo) * stride + c0 + 4 * p;
    const s16x4 lo = __builtin_bit_cast(s16x4, __builtin_amdgcn_ds_read_tr16_b64_v4i16((LAS v4i16_t*)a));
    const s16x4 hi = __builtin_bit_cast(s16x4, __builtin_amdgcn_ds_read_tr16_b64_v4i16((LAS v4i16_t*)(a + dhi * stride)));
    return (bf16x8){lo.x, lo.y, lo.z, lo.w, hi.x, hi.y, hi.z, hi.w};
}
__device__ __forceinline__ f32x4 mfma16(bf16x8 a, bf16x8 b, f32x4 c) { return __builtin_amdgcn_mfma_f32_16x16x32_bf16(a, b, c, 0, 0, 0); }
__device__ __forceinline__ float softcap_f(float z) { const float e = __expf(z * (2.f / SOFTCAP)); return SOFTCAP * (1.f - 2.f / (e + 1.f)); }
__device__ __forceinline__ float logsigmoid_f(float x) { return fminf(x, 0.f) - __logf(1.f + __expf(-fabsf(x))); }
template <bool MAX>
__device__ __forceinline__ float dpp_scan(float v) {
    const int idn = MAX ? (int)0xff800000u : 0;
#define DPP_STEP(ctrl, rmask) do { const float t_ = __builtin_bit_cast(float, __builtin_amdgcn_update_dpp(idn, __builtin_bit_cast(int, v), ctrl, rmask, 0xf, false)); v = MAX ? fmaxf(v, t_) : v + t_; } while (0)
    DPP_STEP(0x111, 0xf); DPP_STEP(0x112, 0xf); DPP_STEP(0x114, 0xf); DPP_STEP(0x118, 0xf);
    DPP_STEP(0x142, 0xa); DPP_STEP(0x143, 0xc);
#undef DPP_STEP
    return v;
}
__device__ __forceinline__ float scan_add(float v, int lane) { (void)lane; return dpp_scan<false>(v); }
__device__ __forceinline__ float scan_max(float v, int lane) { (void)lane; return dpp_scan<true>(v); }
__device__ __forceinline__ void rot8(v4u& a, v4u& b, const GAS f32x4* cs) {
#pragma unroll
    for (int w = 0; w < 4; ++w) { const f32x4 t = cs[w]; const float x1l = bf_lo(a[w]), x1h = bf_hi(a[w]), x2l = bf_lo(b[w]), x2h = bf_hi(b[w]);
        a[w] = pk2(x1l * t.x - x2l * t.y, x1h * t.z - x2h * t.w); b[w] = pk2(x1l * t.y + x2l * t.x, x1h * t.w + x2h * t.z); }
}

__device__ __forceinline__ void rot8v(v4u& a, v4u& b, const f32x4 (&cs)[4]) {
#pragma unroll
    for (int w = 0; w < 4; ++w) { const f32x4 t = cs[w]; const float x1l = bf_lo(a[w]), x1h = bf_hi(a[w]), x2l = bf_lo(b[w]), x2h = bf_hi(b[w]);
        a[w] = pk2(x1l * t.x - x2l * t.y, x1h * t.z - x2h * t.w); b[w] = pk2(x1l * t.y + x2l * t.x, x1h * t.w + x2h * t.z); }
}
template <bool MLSTM, int DBG = 0>
__device__ __forceinline__ void prompt_chain(Frame& F, int unit) {
    constexpr int DK = MLSTM ? DKM : DKR, NDT = MLSTM ? 5 : 4, QS = DK + 16, VS = NDT * 16 + 8, PS = 80, NKT = DK / 128;
    constexpr int L_Q = 0, L_K = L_Q + 64 * QS * 2, L_V = L_K + 64 * QS * 2, L_P = L_V + 64 * VS * 2, L_C = L_P + 64 * PS * 2, L_ARR = L_C + DK * VS * 2;
    static_assert(L_ARR + 2 * 384 * 4 <= LDSCTL_OFF, "prompt chain LDS");
    LAS bf16* Qs = (LAS bf16*)(F.lds + L_Q); LAS bf16* Ks = (LAS bf16*)(F.lds + L_K); LAS bf16* Vx = (LAS bf16*)(F.lds + L_V); LAS bf16* Ps = (LAS bf16*)(F.lds + L_P); LAS bf16* Cb = (LAS bf16*)(F.lds + L_C);
    LAS float* a_g = (LAS float*)(F.lds + L_ARR); LAS float* a_Mx = a_g + 64; LAS float* a_iw = a_g + 128; LAS float* a_emt = a_g + 192; LAS float* a_w = a_g + 256; LAS float* a_sc = a_g + 320;
    int tid = F.tid; asm volatile("" : "+v"(tid));
    const int lane = tid & 63, wave = F.wave, fr = lane & 15, fq = lane >> 4;
    const int NSL = MLSTM ? 8 : 4, NH = MLSTM ? HM : HR;
    const int sl = unit % NSL, h = (unit / NSL) % NH, b = unit / (NSL * NH);
    const int qcol = (MLSTM ? PC_QM : PC_QR) + h * DK, kcol = (MLSTM ? PC_KM : PC_KR) + h * DK, vcol = (MLSTM ? PC_VM + h * DVM : PC_VR + h * DVR) + sl * 64;
    const int hcol = (MLSTM ? h * DVM : HM * DVM + h * DVR) + sl * 64;
    const bf16* proj = (const bf16*)(F.ws + WS_PROJ); const float* gates = (const float*)(F.ws + WS_GATES); bf16* hraw = (bf16*)(F.ws + WS_HRAW);
    float* ssq = (float*)(F.ws + WS_SSQ) + (MLSTM ? 0 : (size_t)M * 64);
    const GAS f32x4* rope = (const GAS f32x4*)(F.ws + WS_ROPE);
    for (int i = tid; i < DK * VS / 2; i += 512) ((LAS unsigned*)Cb)[i] = 0u;
    for (int i = tid; i < 64 * VS / 2; i += 512) ((LAS unsigned*)Vx)[i] = 0u;
    __syncthreads();
    if (MLSTM) { if (tid < 64) Vx[tid * VS + 64] = (bf16)0x3f80; }
    else if (tid < 64) {
        const float lg = logf(1.f - exp2f(-5.f - (float)h)), lsc = -0.5f * logf((float)DKR);
        a_g[tid] = -(float)tid * lg + lsc; a_Mx[tid] = -(float)tid * lg; a_iw[tid] = expf((float)(tid + 1) * lg); a_emt[tid] = 0.f; a_w[tid] = expf((float)(63 - tid) * lg + lsc);
        if (tid == 0) a_sc[0] = expf(64.f * lg);
    }
    f32x4 st[NKT][NDT];
#pragma unroll
    for (int kt = 0; kt < NKT; ++kt)
#pragma unroll
        for (int t = 0; t < NDT; ++t) st[kt][t] = (f32x4){0.f, 0.f, 0.f, 0.f};
    float m_run = 0.f;
    const float bi = MLSTM ? F.in[7][h] : 0.f, bfg = MLSTM ? F.in[8][h] : 0.f;
    v4u pq[4], pk[4], pv; f32x4 pcs[4]; float pig = 0.f, pfg = 0.f;
    const int rA = tid >> 3, cA8 = tid & 7;
#define CHAIN_LOAD(cn) do { const int row0n = b * SEQ + (cn) * 64; \
        if (MLSTM) { _Pragma("unroll") for (int i = 0; i < 4; ++i) { const int id = tid + 512 * i, r = id >> 5, cc = id & 31; \
                pq[i] = *(const GAS v4u*)(proj + (size_t)(row0n + r) * NPROJ + qcol + 8 * cc); pk[i] = *(const GAS v4u*)(proj + (size_t)(row0n + r) * NPROJ + kcol + 8 * cc); } \
            if (wave == 0) { pig = gates[(size_t)(row0n + lane) * 8 + h]; pfg = gates[(size_t)(row0n + lane) * 8 + 4 + h]; } } \
        else { const bf16* pr = proj + (size_t)(row0n + rA) * NPROJ + 8 * cA8; pq[0] = *(const GAS v4u*)(pr + qcol); pq[1] = *(const GAS v4u*)(pr + qcol + 64); pk[0] = *(const GAS v4u*)(pr + kcol); pk[1] = *(const GAS v4u*)(pr + kcol + 64); \
            const GAS f32x4* cs = rope + ((size_t)((cn) * 64 + rA) * 64 + 8 * cA8) / 2; _Pragma("unroll") for (int w = 0; w < 4; ++w) pcs[w] = cs[w]; } \
        pv = *(const GAS v4u*)(proj + (size_t)(row0n + rA) * NPROJ + vcol + 8 * cA8); } while (0)
#define CHAIN_STORE() do { \
        if (MLSTM) { _Pragma("unroll") for (int i = 0; i < 4; ++i) { const int id = tid + 512 * i, r = id >> 5, cc = id & 31; *(LAS v4u*)(Qs + r * QS + 8 * cc) = pq[i]; *(LAS v4u*)(Ks + prow<1>(r) * QS + 8 * cc) = pk[i]; } } \
        else { rot8v(pq[0], pq[1], pcs); rot8v(pk[0], pk[1], pcs); \
            *(LAS v4u*)(Qs + rA * QS + 8 * cA8) = pq[0]; *(LAS v4u*)(Qs + rA * QS + 64 + 8 * cA8) = pq[1]; *(LAS v4u*)(Ks + prow<1>(rA) * QS + 8 * cA8) = pk[0]; *(LAS v4u*)(Ks + prow<1>(rA) * QS + 64 + 8 * cA8) = pk[1]; } \
        *(LAS v4u*)(Vx + prow<2>(rA) * VS + 8 * cA8) = pv; } while (0)
#define CHAIN_GATES(ab) do { \
        const float li = softcap_f(pig + bi), lf = logsigmoid_f(softcap_f(pfg + bfg)); \
        const float bs = scan_add(lf, lane), g = li - bs, Gm = scan_max(g, lane), Mx = fmaxf(m_run, Gm); \
        const float MxL = __shfl(Mx, 63), bL = __shfl(bs, 63); \
        a_g[(ab) + lane] = g; a_Mx[(ab) + lane] = Mx; a_iw[(ab) + lane] = expf(m_run - Mx); a_emt[(ab) + lane] = expf(-(bs + Mx)); a_w[(ab) + lane] = expf(g - MxL); \
        if (lane == 0) a_sc[(ab)] = expf(m_run - MxL); \
        m_run = bL + MxL; } while (0)
    CHAIN_LOAD(0);
    CHAIN_STORE();
    if (MLSTM && wave == 0) CHAIN_GATES(0);
    for (int c = 0; c < SEQ / 64; ++c) {
        const int row0 = b * SEQ + c * 64;
        const int ab = MLSTM ? (c & 1) * 384 : 0, abn = MLSTM ? ((c + 1) & 1) * 384 : 0;
        const bool more = c + 1 < SEQ / 64;
        if (more && !(DBG & 16)) CHAIN_LOAD(c + 1);
        __syncthreads();
        constexpr int NKS = DK / 32;
        const int lt = wave & 3, hf = wave >> 2, l = 16 * lt + fr;
        bf16x8 qf[NKS];
#pragma unroll
        for (int ks = 0; ks < NKS; ++ks) qf[ks] = lds_row8(Qs + l * QS + 32 * ks + 8 * fq);
        if (!(DBG & 1)) {
            const float Mx = a_Mx[ab + l];
            f32x4 acc[2]; acc[0] = (f32x4){0.f, 0.f, 0.f, 0.f}; acc[1] = (f32x4){0.f, 0.f, 0.f, 0.f};
#pragma unroll
            for (int si = 0; si < 2; ++si) { bf16x8 kf[NKS];
#pragma unroll
                for (int ks = 0; ks < NKS; ++ks) kf[ks] = lds_row8(Ks + (16 * (2 * hf + si) + prow<1>(fr)) * QS + 32 * ks + 8 * fq);
#pragma unroll
                for (int ks = 0; ks < NKS; ++ks) acc[si] = mfma16(kf[ks], qf[ks], acc[si]); }
#pragma unroll
            for (int si = 0; si < 2; ++si) { const int stl = 2 * hf + si;
                const f32x4 gv = *(const LAS f32x4*)(a_g + ab + 16 * stl + 4 * fq); float p[4];
#pragma unroll
                for (int r = 0; r < 4; ++r) { const int s_ = 16 * stl + 4 * fq + r; p[r] = (s_ <= l) ? acc[si][r] * __expf(gv[r] - Mx) : 0.f; }
                v2u w; w.x = pk2(p[0], p[1]); w.y = pk2(p[2], p[3]); *(LAS v2u*)(Ps + l * PS + 16 * stl + 4 * fq) = w; }
        }
        if (MLSTM && wave == 0 && more) CHAIN_GATES(abn);
        __syncthreads();
        if (!(DBG & 2)) {
            constexpr int NT = MLSTM ? 3 : 2, NC = NKS / 2;
            f32x4 aQC[NT], aPV[NT];
#pragma unroll
            for (int t = 0; t < NT; ++t) { aQC[t] = (f32x4){0.f, 0.f, 0.f, 0.f}; aPV[t] = (f32x4){0.f, 0.f, 0.f, 0.f}; }
            bf16x8 fs[2][NT][2];
#define DVT(t) (16 * ((t) == 2 ? 4 : 2 * hf + (t)))
#define C_LOAD(set, ch) do { _Pragma("unroll") for (int t = 0; t < NT; ++t) _Pragma("unroll") for (int k = 0; k < 2; ++k) \
                fs[set][t][k] = ((ch) < NC) ? lds_tr8<2>(Cb, VS, 32 * (2 * (ch) + k), DVT(t), fr, fq) : lds_tr8<2>(Vx, VS, 32 * k, DVT(t), fr, fq); } while (0)
            C_LOAD(0, 0); C_LOAD(1, 1);
            const bf16x8 bp0 = lds_row8(Ps + l * PS + 8 * fq), bp1 = lds_row8(Ps + l * PS + 32 + 8 * fq);
            __builtin_amdgcn_sched_barrier(0);
#pragma unroll
            for (int ch = 0; ch <= NC; ++ch) {
                if (ch < NC) {
#pragma unroll
                    for (int k = 0; k < 2; ++k)
#pragma unroll
                        for (int t = 0; t < NT; ++t) aQC[t] = mfma16(fs[ch & 1][t][k], qf[2 * ch + k], aQC[t]);
                } else {
#pragma unroll
                    for (int t = 0; t < NT; ++t) { aPV[t] = mfma16(fs[ch & 1][t][0], bp0, aPV[t]); aPV[t] = mfma16(fs[ch & 1][t][1], bp1, aPV[t]); }
                }
                __builtin_amdgcn_sched_barrier(0);
                if (ch + 2 <= NC) { C_LOAD(ch & 1, ch + 2); __builtin_amdgcn_sched_barrier(0); }
            }
#undef C_LOAD
#undef DVT
            const float iw = a_iw[ab + l]; float inv = 1.f;
            if (MLSTM) { const float den = __shfl(iw * aQC[NT - 1][0] + aPV[NT - 1][0], fr); inv = 1.f / fmaxf(fabsf(den), a_emt[ab + l]); }
            float sq = 0.f;
#pragma unroll
            for (int t = 0; t < 2; ++t) { const f32x4 hv = (iw * aQC[t] + aPV[t]) * inv; sq += (hv.x * hv.x + hv.y * hv.y) + (hv.z * hv.z + hv.w * hv.w);
                v2u w; w.x = pk2(hv.x, hv.y); w.y = pk2(hv.z, hv.w); *(GAS v2u*)(hraw + (size_t)(row0 + l) * D + hcol + 16 * (2 * hf + t) + 4 * fq) = w; }
            sq += __shfl_xor(sq, 16); sq += __shfl_xor(sq, 32);
            if (fq == 0) ssq[(size_t)(row0 + l) * 64 + h * (MLSTM ? 16 : 8) + sl * 2 + hf] = sq;
        }
        if (!(DBG & 4)) {
            const float decay = a_sc[ab];
            bf16x8 bk[NKT][2], av[NDT][2];
#pragma unroll
            for (int t = 0; t < NDT; ++t)
#pragma unroll
                for (int ks = 0; ks < 2; ++ks) av[t][ks] = lds_tr8<2>(Vx, VS, 32 * ks, 16 * t, fr, fq);
#pragma unroll
            for (int ks = 0; ks < 2; ++ks) {
                const f32x4 w0 = *(const LAS f32x4*)(a_w + ab + 32 * ks + 8 * fq), w1 = *(const LAS f32x4*)(a_w + ab + 32 * ks + 8 * fq + 4);
#pragma unroll
                for (int kt = 0; kt < NKT; ++kt) { const bf16x8 raw = lds_tr8<1>(Ks, QS, 32 * ks, 16 * (NKT * wave + kt), fr, fq); v4u pk_;
                    pk_.x = pk2(__uint_as_float((unsigned)(unsigned short)raw[0] << 16) * w0.x, __uint_as_float((unsigned)(unsigned short)raw[1] << 16) * w0.y);
                    pk_.y = pk2(__uint_as_float((unsigned)(unsigned short)raw[2] << 16) * w0.z, __uint_as_float((unsigned)(unsigned short)raw[3] << 16) * w0.w);
                    pk_.z = pk2(__uint_as_float((unsigned)(unsigned short)raw[4] << 16) * w1.x, __uint_as_float((unsigned)(unsigned short)raw[5] << 16) * w1.y);
                    pk_.w = pk2(__uint_as_float((unsigned)(unsigned short)raw[6] << 16) * w1.z, __uint_as_float((unsigned)(unsigned short)raw[7] << 16) * w1.w);
                    bk[kt][ks] = __builtin_bit_cast(bf16x8, pk_); }
            }
#pragma unroll
            for (int kt = 0; kt < NKT; ++kt)
#pragma unroll
                for (int t = 0; t < NDT; ++t) st[kt][t] = st[kt][t] * decay;
#pragma unroll
            for (int ks = 0; ks < 2; ++ks)
#pragma unroll
                for (int t = 0; t < NDT; ++t)
#pragma unroll
                    for (int kt = 0; kt < NKT; ++kt) st[kt][t] = mfma16(av[t][ks], bk[kt][ks], st[kt][t]);
        }
        __syncthreads();
        if (!(DBG & 8))
#pragma unroll
        for (int kt = 0; kt < NKT; ++kt)
#pragma unroll
            for (int t = 0; t < NDT; ++t) { v2u w; w.x = pk2(st[kt][t].x, st[kt][t].y); w.y = pk2(st[kt][t].z, st[kt][t].w);
                *(LAS v2u*)(Cb + (16 * (NKT * wave + kt) + prow<2>(fr)) * VS + 16 * t + 4 * fq) = w; }
        if (more && !(DBG & 16)) CHAIN_STORE();
    }
#undef CHAIN_LOAD
#undef CHAIN_STORE
#undef CHAIN_GATES
    if (MLSTM) {
        float* Co = F.out + O_PC + (size_t)(b * HM + h) * DKM * DVM;
#pragma unroll
        for (int kt = 0; kt < NKT; ++kt) { const int dk = 16 * (NKT * wave + kt) + fr;
#pragma unroll
            for (int t = 0; t < 4; ++t) *(GAS f32x4*)(Co + (size_t)dk * DVM + sl * 64 + 16 * t + 4 * fq) = st[kt][t];
            if (sl == 0 && fq == 0) F.out[O_PN + (size_t)(b * HM + h) * DKM + dk] = st[kt][NDT - 1].x; }
        if (sl == 0 && tid == 0) F.out[O_PM + b * HM + h] = m_run;
    } else {
        float* So = F.out + O_PS + (size_t)(b * HR + h) * DKR * DVR;
#pragma unroll
        for (int kt = 0; kt < NKT; ++kt) { const int dk = 16 * (NKT * wave + kt) + fr;
#pragma unroll
            for (int t = 0; t < 4; ++t) *(GAS f32x4*)(So + (size_t)dk * DVR + sl * 64 + 16 * t + 4 * fq) = st[kt][t]; }
    }
    __syncthreads();
}

struct SuPre { v4u a, b, v; f32x4 cs[4]; float f0, f1, f2, f3; };
template <bool MLSTM>
__device__ __forceinline__ void su_issue(Frame& F, int unit, int tid, SuPre& p) {
    constexpr int DK = MLSTM ? DKM : DKR, DV = MLSTM ? DVM : DVR, NH = MLSTM ? HM : HR;
    const int lane = tid & 63, wave = F.wave, h = unit % NH, b = unit / NH, row0 = MP + b * DECT;
    const int qcol = (MLSTM ? PC_QM : PC_QR) + h * DK, kcol = (MLSTM ? PC_KM : PC_KR) + h * DK, vcol = MLSTM ? PC_VM + h * DVM : PC_VR + h * DVR;
    const bf16* proj = (const bf16*)(F.ws + WS_PROJ); const float* gates = (const float*)(F.ws + WS_GATES);
    if (MLSTM) {
        { const int which = tid >> 8, id = tid & 255, r = id >> 5, cc = id & 31; p.a = *(const GAS v4u*)(proj + (size_t)(row0 + r) * NPROJ + (which ? kcol : qcol) + 8 * cc); }
        { const int r = tid >> 6, cc = tid & 63; p.v = *(const GAS v4u*)(proj + (size_t)(row0 + r) * NPROJ + vcol + 8 * cc); }
        p.f0 = (tid < DK) ? F.in[3][(size_t)(b * HM + h) * DKM + tid] : 0.f;
        if (wave == 7) { const int t = lane & 7; p.f1 = gates[(size_t)(row0 + t) * 8 + h]; p.f2 = gates[(size_t)(row0 + t) * 8 + 4 + h]; p.f3 = F.in[4][b * HM + h]; }
    } else {
        if (tid < 128) { const int which = tid >> 6, id = tid & 63, r = id >> 3, cc = id & 7; const int col = which ? kcol : qcol;
            const GAS f32x4* cs = (const GAS f32x4*)(F.ws + WS_ROPE) + ((size_t)(2048 + r) * 64 + 8 * cc) / 2;
            p.a = *(const GAS v4u*)(proj + (size_t)(row0 + r) * NPROJ + col + 8 * cc); p.b = *(const GAS v4u*)(proj + (size_t)(row0 + r) * NPROJ + col + 64 + 8 * cc);
#pragma unroll
            for (int w = 0; w < 4; ++w) p.cs[w] = cs[w]; }
        if (tid < 256) { const int r = tid >> 5, cc = tid & 31; p.v = *(const GAS v4u*)(proj + (size_t)(row0 + r) * NPROJ + vcol + 8 * cc); }
    }
}
template <bool MLSTM>
__device__ __forceinline__ int sample_unit(Frame& F, int unit, SuPre& p, gu32* qword, unsigned nunits, volatile LAS unsigned* qslot) {
    constexpr int DK = MLSTM ? DKM : DKR, DV = MLSTM ? DVM : DVR, NH = MLSTM ? HM : HR, NCG = DV / 4, NPART = 512 / NCG, RPP = DK / NPART, DPT = DV / 64;
    constexpr int L_QF = 0, L_KF = L_QF + DK * 32, L_KW = L_KF + DK * 32, L_VF = L_KW + DK * 32, L_NF = L_VF + 8 * DV * 4, L_SM = L_NF + DK * 4, L_NP = L_SM + 1024;
    static_assert(L_NP + NPART * 8 * DV * 4 <= LDSCTL_OFF, "sample unit LDS");
    LAS float* qf = (LAS float*)(F.lds + L_QF); LAS float* kf = (LAS float*)(F.lds + L_KF); LAS float* kwf = (LAS float*)(F.lds + L_KW); LAS float* vf = (LAS float*)(F.lds + L_VF);
    LAS float* nf = (LAS float*)(F.lds + L_NF); LAS float* sm = (LAS float*)(F.lds + L_SM); LAS float* np = (LAS float*)(F.lds + L_NP);
    LAS float* s_g = sm, *s_Mx = sm + 8, *s_iw = sm + 16, *s_emt = sm + 24, *s_w = sm + 32, *s_sc = sm + 40, *s_qn = sm + 48, *s_inv = sm + 56, *s_P = sm + 64;
    int tid = F.tid; asm volatile("" : "+v"(tid));
    const int lane = tid & 63, wave = F.wave;
    const int h = unit % NH, b = unit / NH, row0 = MP + b * DECT;
    const int qcol = (MLSTM ? PC_QM : PC_QR) + h * DK, kcol = (MLSTM ? PC_KM : PC_KR) + h * DK, vcol = MLSTM ? PC_VM + h * DVM : PC_VR + h * DVR;
    const int hcol = MLSTM ? h * DVM : HM * DVM + h * DVR;
    const bf16* proj = (const bf16*)(F.ws + WS_PROJ); const float* gates = (const float*)(F.ws + WS_GATES); bf16* hraw = (bf16*)(F.ws + WS_HRAW);
    float* ssq = (float*)(F.ws + WS_SSQ) + (MLSTM ? 0 : (size_t)M * 64);
    const float* S0 = MLSTM ? F.in[2] + (size_t)(b * HM + h) * DKM * DVM : F.in[5] + (size_t)(b * HR + h) * DKR * DVR;
    float* S1 = MLSTM ? F.out + O_SC + (size_t)(b * HM + h) * DKM * DVM : F.out + O_SS + (size_t)(b * HR + h) * DKR * DVR;
    constexpr int QBS = DK + 8; LAS bf16* qb = (LAS bf16*)(F.lds + L_NP); LAS bf16* kb = qb + 8 * QBS;
    if (tid == 0) qslot[0] = __hip_atomic_fetch_add(qword, 1u, RLX_AGENT);
    if (MLSTM) {
        { const int which = tid >> 8, id = tid & 255, r = id >> 5, cc = id & 31; const v4u x = p.a; LAS float* dst = which ? kf : qf;
            *(LAS v4u*)((which ? kb : qb) + r * QBS + 8 * cc) = x;
#pragma unroll
            for (int w = 0; w < 4; ++w) { dst[(8 * cc + 2 * w) * 8 + r] = bf_lo(x[w]); dst[(8 * cc + 2 * w + 1) * 8 + r] = bf_hi(x[w]); } }
    } else {
        if (tid < 128) { const int which = tid >> 6, id = tid & 63, r = id >> 3, cc = id & 7;
            v4u x1 = p.a, x2 = p.b; rot8v(x1, x2, p.cs); LAS float* dst = which ? kf : qf;
            *(LAS v4u*)((which ? kb : qb) + r * QBS + 8 * cc) = x1; *(LAS v4u*)((which ? kb : qb) + r * QBS + 64 + 8 * cc) = x2;
#pragma unroll
            for (int w = 0; w < 4; ++w) { dst[(8 * cc + 2 * w) * 8 + r] = bf_lo(x1[w]); dst[(8 * cc + 2 * w + 1) * 8 + r] = bf_hi(x1[w]);
                dst[(64 + 8 * cc + 2 * w) * 8 + r] = bf_lo(x2[w]); dst[(64 + 8 * cc + 2 * w + 1) * 8 + r] = bf_hi(x2[w]); } }
    }
    if (tid < 8 * DV / 8) { const int r = tid / (DV / 8), cc = tid % (DV / 8); const v4u x = p.v;
#pragma unroll
        for (int w = 0; w < 4; ++w) { vf[r * DV + 8 * cc + 2 * w] = bf_lo(x[w]); vf[r * DV + 8 * cc + 2 * w + 1] = bf_hi(x[w]); } }
    if (MLSTM) { if (tid < DK) nf[tid] = p.f0; }
    if (wave == 7) {
        if (MLSTM) {
            const float m0 = p.f3;
            const float ig = p.f1, fg = p.f2;
            const float li = softcap_f(ig + F.in[7][h]), lf = logsigmoid_f(softcap_f(fg + F.in[8][h]));
            float bs = lf, Gm;
#pragma unroll
            for (int o = 1; o < 8; o <<= 1) { const float tt = __shfl_up(bs, o); if ((lane & 7) >= o) bs += tt; }
            const float g = li - bs; Gm = g;
#pragma unroll
            for (int o = 1; o < 8; o <<= 1) { const float tt = __shfl_up(Gm, o); if ((lane & 7) >= o) Gm = fmaxf(Gm, tt); }
            const float Mx = fmaxf(m0, Gm), MxL = __shfl(Mx, 7), bL = __shfl(bs, 7);
            if (lane < 8) { s_g[lane] = g; s_Mx[lane] = Mx; s_iw[lane] = expf(m0 - Mx); s_emt[lane] = expf(-(bs + Mx)); s_w[lane] = expf(g - MxL); }
            if (lane == 0) { s_sc[0] = expf(m0 - MxL); F.out[O_SM + b * HM + h] = bL + MxL; }
        } else if (lane < 8) {
            const float lg = logf(1.f - exp2f(-5.f - (float)h)), lsc = -0.5f * logf((float)DKR);
            s_g[lane] = -(float)lane * lg + lsc; s_Mx[lane] = -(float)lane * lg; s_iw[lane] = expf((float)(lane + 1) * lg); s_emt[lane] = 0.f; s_w[lane] = expf((float)(7 - lane) * lg + lsc);
            if (lane == 0) s_sc[0] = expf(8.f * lg);
        }
    }
    __syncthreads();
    if (wave == 0) {
        const int fr = lane & 15, fq = lane >> 4; const bf16x8 z8 = (bf16x8){0, 0, 0, 0, 0, 0, 0, 0}; f32x4 d = (f32x4){0.f, 0.f, 0.f, 0.f};
#pragma unroll
        for (int ks = 0; ks < DK / 32; ++ks) { const bf16x8 a = lds_row8(qb + (fr & 7) * QBS + 32 * ks + 8 * fq), bb = lds_row8(kb + (fr & 7) * QBS + 32 * ks + 8 * fq);
            d = mfma16(fr < 8 ? a : z8, fr < 8 ? bb : z8, d); }
        if (fr < 8 && fq < 2) {
#pragma unroll
            for (int r = 0; r < 4; ++r) { const int l = 4 * fq + r; s_P[l * 8 + fr] = (fr <= l) ? d[r] * __expf(s_g[fr] - s_Mx[l]) : 0.f; } }
    }
    for (int i = tid; i < DK * 8; i += 512) kwf[i] = kf[i] * s_w[i & 7];
    if (MLSTM) { float a = 0.f; for (int dk = lane; dk < DK; dk += 64) a += qf[dk * 8 + wave] * nf[dk]; a = wave_sum(a); if (lane == 0) s_qn[wave] = a; }
    __syncthreads();
    const unsigned un = qslot[0];
    if (un < nunits) su_issue<MLSTM>(F, (int)un, tid, p);
    if (MLSTM) {
        if (tid < 8) { float den = s_iw[tid] * s_qn[tid]; for (int s = 0; s < 8; ++s) den += s_P[tid * 8 + s]; s_inv[tid] = 1.f / fmaxf(fabsf(den), s_emt[tid]); }
        if (tid < DK) { float a = s_sc[0] * nf[tid]; for (int s = 0; s < 8; ++s) a += kwf[tid * 8 + s]; F.out[O_SN + (size_t)(b * HM + h) * DKM + tid] = a; }
    } else if (tid < 8) s_inv[tid] = 1.f;
    {
        const int part = __builtin_amdgcn_readfirstlane(tid / NCG), cg = tid % NCG; const float decay = s_sc[0];
        f32x4 vv[8], num[8];
#pragma unroll
        for (int s = 0; s < 8; ++s) { vv[s] = *(const LAS f32x4*)(vf + s * DV + 4 * cg); num[s] = (f32x4){0.f, 0.f, 0.f, 0.f}; }
        const GAS char* srcb = (const GAS char*)(S0 + (size_t)(part * RPP) * DV); GAS char* dstb = (GAS char*)(S1 + (size_t)(part * RPP) * DV); const unsigned vo = (unsigned)cg * 16u;
#define SU_LOAD(buf, r0) do { _Pragma("unroll") for (int j = 0; j < 4; ++j) buf[j] = __builtin_nontemporal_load((const GAS f32x4*)(srcb + (size_t)((r0) + j) * (DV * 4) + vo)); } while (0)
#define SU_COMP(buf, r0) do { _Pragma("unroll") for (int j = 0; j < 4; ++j) { const int dk = part * RPP + (r0) + j; \
                const f32x4 q0 = *(const LAS f32x4*)(qf + dk * 8), q1 = *(const LAS f32x4*)(qf + dk * 8 + 4), k0 = *(const LAS f32x4*)(kwf + dk * 8), k1 = *(const LAS f32x4*)(kwf + dk * 8 + 4); \
                const f32x4 c0 = buf[j]; f32x4 cn = c0 * decay; \
                num[0] += q0.x * c0; num[1] += q0.y * c0; num[2] += q0.z * c0; num[3] += q0.w * c0; num[4] += q1.x * c0; num[5] += q1.y * c0; num[6] += q1.z * c0; num[7] += q1.w * c0; \
                cn += k0.x * vv[0]; cn += k0.y * vv[1]; cn += k0.z * vv[2]; cn += k0.w * vv[3]; cn += k1.x * vv[4]; cn += k1.y * vv[5]; cn += k1.z * vv[6]; cn += k1.w * vv[7]; \
                __builtin_nontemporal_store(cn, (GAS f32x4*)(dstb + (size_t)((r0) + j) * (DV * 4) + vo)); } } while (0)
        static_assert(RPP % 4 == 0 && RPP >= 8, "sample unit row batches");
        f32x4 ca[4], cb[4], cc[4];
        SU_LOAD(ca, 0); SU_LOAD(cb, 4);
        for (int i0 = 0; i0 < RPP; i0 += 12) {
            if (i0 + 8 < RPP) SU_LOAD(cc, i0 + 8);
            SU_COMP(ca, i0);
            if (i0 + 12 < RPP) SU_LOAD(ca, i0 + 12);
            if (i0 + 4 < RPP) SU_COMP(cb, i0 + 4);
            if (i0 + 16 < RPP) SU_LOAD(cb, i0 + 16);
            if (i0 + 8 < RPP) SU_COMP(cc, i0 + 8);
        }
#undef SU_LOAD
#undef SU_COMP
#pragma unroll
        for (int l = 0; l < 8; ++l) *(LAS f32x4*)(np + (size_t)(part * 8 + l) * DV + 4 * cg) = num[l];
    }
    __syncthreads();
    { const int l = wave, dv0 = lane * DPT; const float iw = s_iw[l], inv = s_inv[l]; float hv[DPT]; float sq = 0.f;
#pragma unroll
      for (int j = 0; j < DPT; ++j) { float a = 0.f;
#pragma unroll
          for (int p = 0; p < NPART; ++p) a += np[(size_t)(p * 8 + l) * DV + dv0 + j];
          a *= iw;
#pragma unroll
          for (int s = 0; s < 8; ++s) a += s_P[l * 8 + s] * vf[s * DV + dv0 + j];
          a *= inv; hv[j] = a; sq += a * a; }
      bf16* o = hraw + (size_t)(row0 + l) * D + hcol + dv0;
      if (DPT == 8) { v4u w; w.x = pk2(hv[0], hv[1]); w.y = pk2(hv[2], hv[3]); w.z = pk2(hv[4], hv[5]); w.w = pk2(hv[6], hv[7]); *(GAS v4u*)o = w; }
      else { v2u w; w.x = pk2(hv[0], hv[1]); w.y = pk2(hv[2], hv[3]); *(GAS v2u*)o = w; }
      sq = wave_sum(sq);
      constexpr int NSLOT = MLSTM ? 16 : 8;
      if (lane < NSLOT) ssq[(size_t)(row0 + l) * 64 + h * NSLOT + lane] = (lane == 0) ? sq : 0.f; }
    __syncthreads();
    return un < nunits ? (int)un : -1;
}
template <bool MLSTM>
__device__ __forceinline__ void sample_loop(Frame& F, gu32* qword, unsigned nunits, volatile LAS unsigned* qslot) {
    if (F.tid == 0) qslot[0] = __hip_atomic_fetch_add(qword, 1u, RLX_AGENT);
    __syncthreads();
    int u = (int)qslot[0];
    __syncthreads();
    if ((unsigned)u >= nunits) return;
    SuPre p; su_issue<MLSTM>(F, u, F.tid, p);
    while (u >= 0) u = sample_unit<MLSTM>(F, u, p, qword, nunits, qslot);
}

#ifndef P2_STREAM_ONLY_MOD
#define P2_STREAM_ONLY_MOD 0
#endif
__device__ __forceinline__ void p2_mixers(Frame& F, int rep) {
    volatile LAS unsigned* qslot = F.MISC + 16;
#ifdef CHAIN_DBG
    if (rep == 1) {
        for (;;) {
            if (F.tid == 0) qslot[0] = __hip_atomic_fetch_add(F.ctl + CW_QUEUE + 64 * 3, 1u, RLX_AGENT);
            __syncthreads();
            const unsigned u = qslot[0];
            __syncthreads();
            if (u >= 256u) break;
            if (u < 128u) prompt_chain<true, CHAIN_DBG>(F, (int)u); else prompt_chain<false, CHAIN_DBG>(F, (int)u - 128);
        }
        return;
    }
#endif
    const bool chain_ok = (P2_STREAM_ONLY_MOD == 0) || ((int)blockIdx.x % (P2_STREAM_ONLY_MOD ? P2_STREAM_ONLY_MOD : 1)) != 0;
    if (chain_ok && !(PROBE_REPEAT == 21 && rep == 1)) for (;;) {
        if (F.tid == 0) qslot[0] = __hip_atomic_fetch_add(F.ctl + CW_QUEUE + 64 * (2 + rep), 1u, RLX_AGENT);
        __syncthreads();
        const unsigned u = qslot[0];
        __syncthreads();
        if (u >= 256u) break;
        if (u < 128u) prompt_chain<true>(F, (int)u); else prompt_chain<false>(F, (int)u - 128);
    }
    sample_loop<true>(F, F.ctl + CW_QUEUE + 64 * rep, 512u, qslot);
    sample_loop<false>(F, F.ctl + CW_QUEUE + 64 * (4 + rep), 1024u, qslot);
}

__device__ __forceinline__ void p3_norm_gate(Frame& F) {
    const int gw = F.vcu * NWAVES + F.wave, NGW = F.G * NWAVES, lane = F.lane;
    const bf16* proj = (const bf16*)(F.ws + WS_PROJ); const bf16* hraw = (const bf16*)(F.ws + WS_HRAW); bf16* cat = (bf16*)(F.ws + WS_CAT);
    const float* ssq_m = (const float*)(F.ws + WS_SSQ); const float* ssq_r = ssq_m + (size_t)M * 64;
    f32x4 gg[8][2];
#pragma unroll
    for (int i = 0; i < 8; ++i) { const int col = 8 * lane + 512 * i; const float* gp = (i < 4) ? F.in[9] + col : F.in[10] + (col - 2048); gg[i][0] = *(const GAS f32x4*)gp; gg[i][1] = *(const GAS f32x4*)(gp + 4); }
    for (int m = gw; m < M; m += NGW) {
        float sm = ssq_m[(size_t)m * 64 + lane], sr = ssq_r[(size_t)m * 64 + lane];
        v4u hx[8], gx[8];
#pragma unroll
        for (int i = 0; i < 8; ++i) { const int col = 8 * lane + 512 * i; hx[i] = *(const GAS v4u*)(hraw + (size_t)m * D + col); gx[i] = *(const GAS v4u*)(proj + (size_t)m * NPROJ + (i < 4 ? PC_OM + col : PC_GR + (col - 2048))); }
        sm += __shfl_xor(sm, 1); sm += __shfl_xor(sm, 2); sm += __shfl_xor(sm, 4); sm += __shfl_xor(sm, 8);
        sr += __shfl_xor(sr, 1); sr += __shfl_xor(sr, 2); sr += __shfl_xor(sr, 4);
        const float rm = 1.f / sqrtf(sm * (1.f / DVM) + RMS_EPS), rr = 1.f / sqrtf(sr * (1.f / DVR) + RMS_EPS);
#pragma unroll
        for (int i = 0; i < 8; ++i) {
            const int col = 8 * lane + 512 * i;
            float rs;
            if (i < 4) rs = __shfl(rm, 16 * i);
            else { const float r0 = __shfl(rr, 16 * (i - 4)), r1 = __shfl(rr, 16 * (i - 4) + 8); rs = lane < 32 ? r0 : r1; }
            const float g8[8] = {gg[i][0].x, gg[i][0].y, gg[i][0].z, gg[i][0].w, gg[i][1].x, gg[i][1].y, gg[i][1].z, gg[i][1].w};
            v4u o;
#pragma unroll
            for (int w = 0; w < 4; ++w) { const float h0 = bf_lo(hx[i][w]), h1 = bf_hi(hx[i][w]), z0 = bf_lo(gx[i][w]), z1 = bf_hi(gx[i][w]);
                const float s0 = 1.f / (1.f + __expf(-z0)), s1 = 1.f / (1.f + __expf(-z1));
                const float a0 = (i < 4) ? s0 : z0 * s0, a1 = (i < 4) ? s1 : z1 * s1;
                o[w] = pk2(h0 * rs * g8[2 * w] * a0, h1 * rs * g8[2 * w + 1] * a1); }
            *(GAS v4u*)(cat + (size_t)m * D + col) = o;
        }
    }
}

struct Args { const float* in[17]; float* out; unsigned char* ws; int ph_lo, ph_hi; };
__global__ void __launch_bounds__(NWAVES * 64, 2) hymba_fwd(Args args) {
    extern __shared__ __attribute__((aligned(16))) unsigned char lds[];
    Frame F;
    F.lds = (LAS unsigned char*)lds;
    F.MISC = (volatile LAS unsigned*)(F.lds + MISC_OFF);
    F.tid = threadIdx.x; F.lane = F.tid & 63; F.wave = __builtin_amdgcn_readfirstlane(F.tid >> 6);
    F.G = gridDim.x; { const int bx = blockIdx.x; F.vcu = (F.G % 8 == 0) ? (bx % 8) * (F.G / 8) + bx / 8 : bx; }
#pragma unroll
    for (int i = 0; i < 17; ++i) F.in[i] = args.in[i];
    F.out = args.out; F.ws = args.ws;
    F.ctl = (gu32*)(F.ws + WS_CTL);
    for (int u = F.tid; u < (LDS_BYTES - LDSCTL_OFF) / 4; u += NWAVES * 64) ((LAS unsigned*)(F.lds + LDSCTL_OFF))[u] = 0u;
    __syncthreads();
    XcdBarrier bar; bar.bar = (unsigned*)(F.ctl + CW_BAR); bar.x = 0; bar.st = nullptr;
    if (N_LAUNCHES == 1) bar = xcd_barrier_post((unsigned*)(F.ctl + CW_BAR), F.MISC + 8);
#define GRID_BAR() do { if (N_LAUNCHES == 1) xcd_barrier(bar); } while (0)
    const int lo = args.ph_lo, hi = args.ph_hi;
#define IN(k) (lo <= (k) && (k) < hi)
#define BOTH(k) (IN(k) && IN((k) + 1))
    bf16* XN = (bf16*)(F.ws + WS_XN);
#define RUN2(k, body) do { body; if (PROBE_REPEAT == (k)) { GRID_BAR(); body; } } while (0)
    if (IN(0)) { RUN2(0, p0_prologue(F)); if (BOTH(0)) GRID_BAR(); }
    if (IN(1)) {
        pg8::Gemm g{XN, (const bf16*)(F.ws + WS_WIN), M, NPROJ_PAD, D, D}; pg8::StaticOrder S; S.init(M, NPROJ_PAD, F.G, (int)blockIdx.x);
        pg8::EpiProj E{(bf16*)(F.ws + WS_PROJ), NPROJ, (float*)(F.ws + WS_GATES), NPROJ / 256, 4, 0.0625f};
        typedef pg8::WFill<D, FF> WF; const int f0 = (int)((long long)F.vcu * WF::NI / F.G), f1 = (int)((long long)(F.vcu + 1) * WF::NI / F.G);
        WF FL{F.in[14], F.in[15], (bf16*)(F.ws + WS_WUP), (bf16*)(F.ws + WS_WDN), __builtin_amdgcn_readfirstlane(f0), __builtin_amdgcn_readfirstlane(f1),
              __builtin_amdgcn_readfirstlane(f0), __builtin_amdgcn_readfirstlane(f1 - f0), __builtin_amdgcn_readfirstlane(f1 > f0 ? (F.vcu * 37) % (f1 - f0) : 0)};
        RUN2(1, (pg8::gemm_phase<pg8::EpiProj, pg8::StaticOrder, true, true, WF>(F.lds, g, S, E, FL)));
        if (BOTH(1)) GRID_BAR();
    }
    if (IN(2)) {
#ifdef CHAIN_DBG
        p2_mixers(F, 1); GRID_BAR();
#endif
        p2_mixers(F, 0); if (PROBE_REPEAT == 2 || PROBE_REPEAT == 21) { GRID_BAR(); p2_mixers(F, 1); } if (BOTH(2)) GRID_BAR(); }
    if (IN(3)) { RUN2(3, p3_norm_gate(F)); if (BOTH(3)) GRID_BAR(); }
    bf16* X1B = (bf16*)(F.ws + WS_X1B); float* rowssq = (float*)(F.ws + WS_CTL) + CW_ROWSSQ;
    if (IN(4)) {
        pg8::Gemm g{(const bf16*)(F.ws + WS_CAT), (const bf16*)(F.ws + WS_WOUT), MP, D, D, D}; pg8::StaticOrder S; S.init(MP, D, F.G, (int)blockIdx.x);
        pg8::EpiX1 E{F.in[0], F.in[13], X1B, XN, D, D, rowssq};
        pg8::Gemm g2{(const bf16*)(F.ws + WS_CAT), (const bf16*)(F.ws + WS_WOUT), M, D, D / 4, D}; pg8::SplitTailOrder S2{MP / 256, D / 4, F.G, (int)blockIdx.x};
        pg8::EpiPartF32 E2{(float*)(F.ws + WS_PART), D, MP / 256, D / 4, (size_t)MS * D};
        pg8::gemm_phase<pg8::EpiX1, pg8::StaticOrder, true, true>(F.lds, g, S, E);
        pg8::gemm_phase<pg8::EpiPartF32, pg8::SplitTailOrder, true, true>(F.lds, g2, S2, E2);
        if (BOTH(4)) GRID_BAR();
    }
    if (IN(5)) { const int gw = F.vcu * NWAVES + F.wave, NGW = F.G * NWAVES;
        for (int m = MP + gw; m < M; m += NGW) x1_sample_row(F.in[1] + (size_t)(m - MP) * D, (const float*)(F.ws + WS_PART) + (size_t)(m - MP) * D, (size_t)MS * D, F.in[13], X1B + (size_t)m * D, XN + (size_t)m * D, rowssq + m, F.lane);
        if (BOTH(5)) GRID_BAR(); }
    if (IN(6)) {
        pg8::Gemm g{XN, (const bf16*)(F.ws + WS_WUP), M, FF, D, D}; pg8::StaticOrder S; S.init(M, FF, F.G, (int)blockIdx.x);
        pg8::EpiRelu2S E{(bf16*)(F.ws + WS_U), FF, rowssq, 1.f / D, RMS_EPS};
        pg8::gemm_phase<pg8::EpiRelu2S, pg8::StaticOrder, true, true>(F.lds, g, S, E);
        if (BOTH(6)) GRID_BAR();
    }
    if (IN(7)) {
        pg8::Gemm g{(const bf16*)(F.ws + WS_U), (const bf16*)(F.ws + WS_WDN), MP, D, FF, FF}; pg8::StaticOrder S; S.init(MP, D, F.G, (int)blockIdx.x);
        pg8::EpiX2 E{X1B, D};
        pg8::Gemm g2{(const bf16*)(F.ws + WS_U), (const bf16*)(F.ws + WS_WDN), M, D, FF / 4, FF}; pg8::SplitTailOrder S2{MP / 256, FF / 4, F.G, (int)blockIdx.x};
        pg8::EpiPartF32 E2{(float*)(F.ws + WS_PART), D, MP / 256, FF / 4, (size_t)MS * D};
        pg8::gemm_phase<pg8::EpiX2, pg8::StaticOrder, true, true>(F.lds, g, S, E);
        pg8::gemm_phase<pg8::EpiPartF32, pg8::SplitTailOrder, true, true>(F.lds, g2, S2, E2);
        if (BOTH(7)) GRID_BAR();
    }
    if (IN(8)) { const int gw = F.vcu * NWAVES + F.wave, NGW = F.G * NWAVES; const float* gfin = F.in[16]; const float* partb = (const float*)(F.ws + WS_PART);
        for (int rep8 = 0; rep8 < (PROBE_REPEAT == 8 ? 2 : 1); ++rep8) {
        v2u cur[16], nxt[16];
        if (NGW == 2048) {
            int r0, nr;
            if (gw < 1024) { const int m = MP + gw; frow_load(cur, X1B + (size_t)m * D, F.lane); frow_finish<true>(cur, partb + (size_t)(m - MP) * D, (size_t)MS * D, gfin, F.out + O_Y + (size_t)m * D, F.lane); r0 = 2 * gw; nr = 2; }
            else { r0 = 2048 + (gw - 1024) * 6; nr = 6; }
            frow_load(cur, X1B + (size_t)r0 * D, F.lane);
            for (int i = 0; i < nr; ++i) { const int m = r0 + i;
                if (i + 1 < nr) frow_load(nxt, X1B + (size_t)(m + 1) * D, F.lane);
                frow_finish<false>(cur, nullptr, 0, gfin, F.out + O_Y + (size_t)m * D, F.lane);
#pragma unroll
                for (int j = 0; j < 16; ++j) cur[j] = nxt[j]; }
        } else {
            for (int m = gw; m < M; m += NGW) { frow_load(cur, X1B + (size_t)m * D, F.lane);
                if (m < MP) frow_finish<false>(cur, nullptr, 0, gfin, F.out + O_Y + (size_t)m * D, F.lane);
                else frow_finish<true>(cur, partb + (size_t)(m - MP) * D, (size_t)MS * D, gfin, F.out + O_Y + (size_t)m * D, F.lane); }
        } } }
#undef RUN2
#undef IN
#undef BOTH
}

extern "C" void kernel_launch(void* const* d_in, const int* in_sizes, int n_in, void* d_out, int out_size, void* d_ws, size_t ws_size, hipStream_t stream) {
    static int grid = 0;
    if (grid == 0) {
        if (n_in != 17 || in_sizes[0] != MP * D || (size_t)out_size != O_END || ws_size < WS_END) { fprintf(stderr, "kernel_launch: unexpected shapes: n_in %d in0 %d out %d ws %zu (need %zu); nothing launched\n", n_in, n_in > 0 ? in_sizes[0] : -1, out_size, ws_size, (size_t)WS_END); grid = -1; return; }
        int dev = 0, cus = 0, per_cu = 0;
        if (hipGetDevice(&dev) != hipSuccess || hipDeviceGetAttribute(&cus, hipDeviceAttributeMultiprocessorCount, dev) != hipSuccess) { fprintf(stderr, "kernel_launch: device query failed\n"); grid = -1; return; }
        if (hipFuncSetAttribute((const void*)hymba_fwd, hipFuncAttributeMaxDynamicSharedMemorySize, LDS_BYTES) != hipSuccess) { fprintf(stderr, "kernel_launch: hipFuncSetAttribute(%d B LDS) failed\n", LDS_BYTES); grid = -1; return; }
        if (hipOccupancyMaxActiveBlocksPerMultiprocessor(&per_cu, (const void*)hymba_fwd, NWAVES * 64, LDS_BYTES) != hipSuccess || per_cu < 1)
            fprintf(stderr, "kernel_launch: note: occupancy query reports %d workgroups per CU\n", per_cu);
        (void)hipGetLastError();
        grid = cus;
    }
    if (grid < 0) return;
    if (hipMemsetAsync((char*)d_ws + WS_CTL, 0, CTL_ZERO_BYTES, stream) != hipSuccess) { fprintf(stderr, "kernel_launch: memset failed\n"); return; }
    Args a{};
    for (int i = 0; i < 17; ++i) a.in[i] = (const float*)d_in[i];
    a.out = (float*)d_out; a.ws = (unsigned char*)d_ws;
    for (int li = 0; li < N_LAUNCHES; ++li) {
        a.ph_lo = (N_LAUNCHES == 1) ? 0 : li; a.ph_hi = (N_LAUNCHES == 1) ? N_PHASES : li + 1;
        hipLaunchKernelGGL(hymba_fwd, dim3(grid), dim3(NWAVES * 64), LDS_BYTES, stream, a);
        const hipError_t le = hipPeekAtLastError();
        if (le != hipSuccess) { fprintf(stderr, "kernel_launch: launch %d failed: %s\n", li, hipGetErrorName(le)); break; }
    }
}
```

```cpp
#include <hip/hip_runtime.h>
#include <cstdio>
#include <cstdint>
namespace pg8 {
#define PG8_LAS __attribute__((address_space(3)))
typedef unsigned short bf16_t;
typedef short bf16x8 __attribute__((ext_vector_type(8)));
typedef float f32x4 __attribute__((ext_vector_type(4)));
typedef unsigned u32x4 __attribute__((ext_vector_type(4)));
constexpr int BM = 256, BK = 64, HALF = 128, HTB = HALF * BK * 2  , STAGE_BYTES = 8 * HTB, NXCD = 8, WGM = 8;

__host__ __device__ __forceinline__ int lds_byte(int r, int c) { const int st = (r >> 4) * 2 + (c >> 5), rr = r & 15, cc = c & 31, ob = rr * 64 + cc * 2; return st * 1024 + (ob ^ (((ob >> 9) & 1) << 5)); }
__host__ __device__ __forceinline__ void stage_rc(int b, int& R, int& C) { const int st = b / 1024, sb = b % 1024, swz = sb ^ (((sb >> 9) & 1) << 5); R = (st >> 1) * 16 + swz / 64; C = (st & 1) * 32 + (swz % 64) / 2; }
__host__ __device__ __forceinline__ int perm32(int rho) { const int n = rho >> 4, i = rho & 15; return 8 * (i >> 2) + 4 * n + (i & 3); }

struct Unit { int pm, pn, k0; };
struct Gemm { const bf16_t* A; const bf16_t* Bt; int M, N, K, ld; };

struct StaticOrder {
    int nM, nN, nwg, G, c, wgm;
    __host__ __device__ void init(int M, int N, int G_, int c_) { nM = M / BM; nN = N / BM; nwg = nM * nN; G = G_; c = c_; wgm = 6; }
    __host__ __device__ bool next(int i, Unit& u) const {
        const long L = (long)i * G + c; if (L >= nwg) return false;
        int wgid = (int)L; { const int q = nwg / NXCD, r = nwg % NXCD, xcd = wgid % NXCD, off = wgid / NXCD; wgid = (xcd < r ? xcd * (q + 1) : r * (q + 1) + (xcd - r) * q) + off; }
        const int nig = wgm * nN, gid = wgid / nig, fm = gid * wgm, gsz = (nM - fm) < wgm ? (nM - fm) : wgm;
        u.pm = fm + ((wgid % nig) % gsz); u.pn = (wgid % nig) / gsz; u.k0 = 0; return true;
    }
    __device__ __forceinline__ void a_ready(const Unit&) const {}
    __device__ __forceinline__ void done(const Unit&) const {}
};

typedef float f32x2_c __attribute__((ext_vector_type(2))); typedef __bf16 bf16x2_c __attribute__((ext_vector_type(2)));
__device__ __forceinline__ unsigned cvt_pk_bf16(float lo, float hi) { const f32x2_c v = {lo, hi}; const bf16x2_c b = __builtin_convertvector(v, bf16x2_c); return __builtin_bit_cast(unsigned, b); }

struct EpiProj {
    static constexpr bool PERM = true, AFTER_DRAIN = false;
    bf16_t* O; int ldc; float* gates; int gate_pn; int nscale; float sc0;
    __device__ __forceinline__ void operator()(const f32x4 (&acc)[2][2][4][2], const Unit& u, int wr, int wc, int fr, int fq) const {
        const int row0 = u.pm * BM + wr * 64 + fr;
        if (u.pn == gate_pn) {
            if (wc == 0 && fq == 0) {
#pragma unroll
                for (int ai = 0; ai < 2; ++ai)
#pragma unroll
                    for (int m = 0; m < 4; ++m) { float* g = gates + (size_t)(row0 + ai * HALF + m * 16) * 8; *(f32x4*)g = acc[ai][0][m][0]; *(f32x4*)(g + 4) = acc[ai][0][m][1]; }
            }
            return;
        }
        const float sc = (u.pn < nscale) ? sc0 : 1.f;
        const int col0 = u.pn * BM + wc * 32 + 8 * fq;
#pragma unroll
        for (int ai = 0; ai < 2; ++ai)
#pragma unroll
            for (int m = 0; m < 4; ++m) { bf16_t* rowp = O + (size_t)(row0 + ai * HALF + m * 16) * ldc + col0;
#pragma unroll
                for (int bj = 0; bj < 2; ++bj) { const f32x4 v0 = acc[ai][bj][m][0] * sc, v1 = acc[ai][bj][m][1] * sc;
                    u32x4 w; w.x = cvt_pk_bf16(v0[0], v0[1]); w.y = cvt_pk_bf16(v0[2], v0[3]); w.z = cvt_pk_bf16(v1[0], v1[1]); w.w = cvt_pk_bf16(v1[2], v1[3]);
                    *(u32x4*)(rowp + bj * HALF) = w; } }
    }
};
struct EpiRelu2 {
    static constexpr bool PERM = true, AFTER_DRAIN = false;
    bf16_t* O; int ldc;
    __device__ __forceinline__ void operator()(const f32x4 (&acc)[2][2][4][2], const Unit& u, int wr, int wc, int fr, int fq) const {
        const int row0 = u.pm * BM + wr * 64 + fr, col0 = u.pn * BM + wc * 32 + 8 * fq;
#pragma unroll
        for (int ai = 0; ai < 2; ++ai)
#pragma unroll
            for (int m = 0; m < 4; ++m) { bf16_t* rowp = O + (size_t)(row0 + ai * HALF + m * 16) * ldc + col0;
#pragma unroll
                for (int bj = 0; bj < 2; ++bj) { f32x4 v0 = acc[ai][bj][m][0], v1 = acc[ai][bj][m][1];
#pragma unroll
                    for (int j = 0; j < 4; ++j) { const float a = fmaxf(v0[j], 0.f), b = fmaxf(v1[j], 0.f); v0[j] = a * a; v1[j] = b * b; }
                    u32x4 w; w.x = cvt_pk_bf16(v0[0], v0[1]); w.y = cvt_pk_bf16(v0[2], v0[3]); w.z = cvt_pk_bf16(v1[0], v1[1]); w.w = cvt_pk_bf16(v1[2], v1[3]);
                    *(u32x4*)(rowp + bj * HALF) = w; } }
    }
};
struct EpiResF32 {
    static constexpr bool PERM = false, AFTER_DRAIN = false;
    const float* res_lo; const float* res_hi; int split_pm; float* C; int ldc;
    __device__ __forceinline__ void operator()(const f32x4 (&acc)[2][2][4][2], const Unit& u, int wr, int wc, int fr, int fq) const {
        const int row0 = u.pm * BM + wr * 64 + fr, col0 = u.pn * BM + wc * 32 + 4 * fq;
        const float* rb = (u.pm < split_pm) ? res_lo : res_hi - (size_t)split_pm * BM * ldc;
#pragma unroll
        for (int ai = 0; ai < 2; ++ai)
#pragma unroll
            for (int m = 0; m < 4; ++m) { const size_t off = (size_t)(row0 + ai * HALF + m * 16) * ldc + col0;
                f32x4 o[2][2];
#pragma unroll
                for (int bj = 0; bj < 2; ++bj)
#pragma unroll
                    for (int n = 0; n < 2; ++n) o[bj][n] = *(const f32x4*)(rb + off + bj * HALF + n * 16) + acc[ai][bj][m][n];
#pragma unroll
                for (int bj = 0; bj < 2; ++bj)
#pragma unroll
                    for (int n = 0; n < 2; ++n) *(f32x4*)(C + off + bj * HALF + n * 16) = o[bj][n];
                asm volatile("" ::: "memory"); }
    }
};

struct EpiX1 {
    static constexpr bool PERM = true, AFTER_DRAIN = false;
    const float* res; const float* g; bf16_t* X1; bf16_t* XN; int ldr, ldx; float* rowssq;
    __device__ __forceinline__ void operator()(const f32x4 (&acc)[2][2][4][2], const Unit& u, int wr, int wc, int fr, int fq) const {
        const int row0 = u.pm * BM + wr * 64 + fr, col0 = u.pn * BM + wc * 32 + 8 * fq;
        f32x4 gv[2][2];
#pragma unroll
        for (int bj = 0; bj < 2; ++bj)
#pragma unroll
            for (int n = 0; n < 2; ++n) gv[bj][n] = *(const f32x4*)(g + col0 + bj * HALF + 4 * n);
#pragma unroll
        for (int ai = 0; ai < 2; ++ai)
#pragma unroll
            for (int m = 0; m < 4; ++m) { const int row = row0 + ai * HALF + m * 16; float ss = 0.f;
#pragma unroll
                for (int bj = 0; bj < 2; ++bj) { const float* rp = res + (size_t)row * ldr + col0 + bj * HALF;
                    const f32x4 v0 = *(const f32x4*)rp + acc[ai][bj][m][0], v1 = *(const f32x4*)(rp + 4) + acc[ai][bj][m][1];
                    ss += (v0[0] * v0[0] + v0[1] * v0[1]) + (v0[2] * v0[2] + v0[3] * v0[3]) + (v1[0] * v1[0] + v1[1] * v1[1]) + (v1[2] * v1[2] + v1[3] * v1[3]);
                    u32x4 w; w.x = cvt_pk_bf16(v0[0], v0[1]); w.y = cvt_pk_bf16(v0[2], v0[3]); w.z = cvt_pk_bf16(v1[0], v1[1]); w.w = cvt_pk_bf16(v1[2], v1[3]);
                    *(u32x4*)(X1 + (size_t)row * ldx + col0 + bj * HALF) = w;
                    const f32x4 n0 = v0 * gv[bj][0], n1 = v1 * gv[bj][1];
                    w.x = cvt_pk_bf16(n0[0], n0[1]); w.y = cvt_pk_bf16(n0[2], n0[3]); w.z = cvt_pk_bf16(n1[0], n1[1]); w.w = cvt_pk_bf16(n1[2], n1[3]);
                    *(u32x4*)(XN + (size_t)row * ldx + col0 + bj * HALF) = w; }
                ss += __shfl_xor(ss, 16); ss += __shfl_xor(ss, 32);
                if (fq == 0) (void)__hip_atomic_fetch_add(rowssq + row, ss, __ATOMIC_RELAXED, __HIP_MEMORY_SCOPE_AGENT);
                asm volatile("" ::: "memory"); }
    }
};
struct EpiRelu2S {
    static constexpr bool PERM = true, AFTER_DRAIN = false;
    bf16_t* O; int ldc; const float* rowssq; float inv_n, eps;
    __device__ __forceinline__ void operator()(const f32x4 (&acc)[2][2][4][2], const Unit& u, int wr, int wc, int fr, int fq) const {
        const int row0 = u.pm * BM + wr * 64 + fr, col0 = u.pn * BM + wc * 32 + 8 * fq;
#pragma unroll
        for (int ai = 0; ai < 2; ++ai)
#pragma unroll
            for (int m = 0; m < 4; ++m) { const int row = row0 + ai * HALF + m * 16; const float s2 = 1.f / (rowssq[row] * inv_n + eps); bf16_t* rowp = O + (size_t)row * ldc + col0;
#pragma unroll
                for (int bj = 0; bj < 2; ++bj) { f32x4 v0 = acc[ai][bj][m][0], v1 = acc[ai][bj][m][1];
#pragma unroll
                    for (int j = 0; j < 4; ++j) { const float a = fmaxf(v0[j], 0.f), b = fmaxf(v1[j], 0.f); v0[j] = a * a * s2; v1[j] = b * b * s2; }
                    u32x4 w; w.x = cvt_pk_bf16(v0[0], v0[1]); w.y = cvt_pk_bf16(v0[2], v0[3]); w.z = cvt_pk_bf16(v1[0], v1[1]); w.w = cvt_pk_bf16(v1[2], v1[3]);
                    *(u32x4*)(rowp + bj * HALF) = w; } }
    }
};
struct EpiX2 {
    static constexpr bool PERM = true, AFTER_DRAIN = false;
    bf16_t* X; int ldx;
    __device__ __forceinline__ void operator()(const f32x4 (&acc)[2][2][4][2], const Unit& u, int wr, int wc, int fr, int fq) const {
        const int row0 = u.pm * BM + wr * 64 + fr, col0 = u.pn * BM + wc * 32 + 8 * fq;
#pragma unroll
        for (int ai = 0; ai < 2; ++ai)
#pragma unroll
            for (int m = 0; m < 4; ++m) { bf16_t* rowp = X + (size_t)(row0 + ai * HALF + m * 16) * ldx + col0;
                u32x4 x[2];
#pragma unroll
                for (int bj = 0; bj < 2; ++bj) x[bj] = *(const u32x4*)(rowp + bj * HALF);
#pragma unroll
                for (int bj = 0; bj < 2; ++bj) { const f32x4 a0 = acc[ai][bj][m][0], a1 = acc[ai][bj][m][1]; u32x4 w;
                    w.x = cvt_pk_bf16(__uint_as_float(x[bj].x << 16) + a0[0], __uint_as_float(x[bj].x & 0xffff0000u) + a0[1]);
                    w.y = cvt_pk_bf16(__uint_as_float(x[bj].y << 16) + a0[2], __uint_as_float(x[bj].y & 0xffff0000u) + a0[3]);
                    w.z = cvt_pk_bf16(__uint_as_float(x[bj].z << 16) + a1[0], __uint_as_float(x[bj].z & 0xffff0000u) + a1[1]);
                    w.w = cvt_pk_bf16(__uint_as_float(x[bj].w << 16) + a1[2], __uint_as_float(x[bj].w & 0xffff0000u) + a1[3]);
                    *(u32x4*)(rowp + bj * HALF) = w; }
                asm volatile("" ::: "memory"); }
    }
};
struct SplitTailOrder {
    int pm0, kq_len, G, c;
    __device__ __forceinline__ bool next(int i, Unit& u) const {
        const int L = i * G + c; if (L >= 256) return false;
        const int x = L & 7, idx = L >> 3; u.pn = (x & 1) * 8 + (idx & 7); u.pm = pm0 + (idx >> 3); u.k0 = (x >> 1) * kq_len; return true; }
    __device__ __forceinline__ void a_ready(const Unit&) const {}
    __device__ __forceinline__ void done(const Unit&) const {}
};
struct EpiPartF32 {
    static constexpr bool PERM = false, AFTER_DRAIN = false;
    float* P; int ldc, pm0, kq_len; size_t qstride;
    __device__ __forceinline__ void operator()(const f32x4 (&acc)[2][2][4][2], const Unit& u, int wr, int wc, int fr, int fq) const {
        const int row0 = (u.pm - pm0) * BM + wr * 64 + fr, col0 = u.pn * BM + wc * 32 + 4 * fq; float* base = P + (size_t)(u.k0 / kq_len) * qstride;
#pragma unroll
        for (int ai = 0; ai < 2; ++ai)
#pragma unroll
            for (int m = 0; m < 4; ++m) { const size_t off = (size_t)(row0 + ai * HALF + m * 16) * ldc + col0;
#pragma unroll
                for (int bj = 0; bj < 2; ++bj)
#pragma unroll
                    for (int n = 0; n < 2; ++n) *(f32x4*)(base + off + bj * HALF + n * 16) = acc[ai][bj][m][n]; }
    }
};

struct NoFill { static constexpr bool ON = false; int fi, fend; __device__ __forceinline__ void set_wave(int) {} };
template <int DD, int DF>
struct WFill {
    static constexpr bool ON = true;
    static constexpr int NI_UP = (DD / 64) * (DF / 64), NI_DN = (DF / 64) * (DD / 64), NI = NI_UP + NI_DN;
    static constexpr int LG_UP = __builtin_ctz(DD / 64), LG_DN = __builtin_ctz(DF / 64);
    static_assert((DD / 64) == (1 << LG_UP) && (DF / 64) == (1 << LG_DN), "WFill: K extents must be 64 * 2^n");
    const float* Wup; const float* Wdn; void* WupT; void* WdnT; int fi, fend, base, cnt, rot0;
    typedef unsigned v4u_f __attribute__((ext_vector_type(4)));
    __device__ __forceinline__ void set_wave(int) {}
    __device__ __forceinline__ int rotated(int id) const { int x = id - base + rot0; x = x >= cnt ? x - cnt : x; return __builtin_amdgcn_readfirstlane(base + x); }
    __device__ __forceinline__ void issue(int id, PG8_LAS unsigned char* buf, int wid, int lane) const {
        id = rotated(id);
        const bool up = id < NI_UP; const int j = up ? id : id - NI_UP, sh = up ? LG_UP : LG_DN, nb = j >> sh, kb = j & ((1 << sh) - 1), N = up ? DF : DD;
        const char* src = (const char*)(up ? Wup : Wdn) + ((size_t)(64 * kb) * N + 64 * nb + 8 * wid) * 4;
        const unsigned lo = (unsigned)(lane >> 3) * (unsigned)(N * 4) + (unsigned)(lane & 7) * 4u;
#pragma unroll
        for (int r = 0; r < 8; ++r) __builtin_amdgcn_global_load_lds((const unsigned*)(src + (size_t)(8 * r) * N * 4 + lo), (PG8_LAS unsigned*)(buf + r * 288), 4, 0, 0);
    }
    __device__ __forceinline__ void read(float (&raw)[8], const PG8_LAS unsigned char* buf, int lane) const {
        const int n = lane >> 3, kq = lane & 7;
#pragma unroll
        for (int j = 0; j < 8; ++j) raw[j] = *(const PG8_LAS float*)(buf + kq * 288 + j * 32 + n * 4);
    }
    __device__ __forceinline__ void store(const float (&raw)[8], int id, int wid, int lane) const {
        id = rotated(id);
        const bool up = id < NI_UP; const int j = up ? id : id - NI_UP, sh = up ? LG_UP : LG_DN, nb = j >> sh, kb = j & ((1 << sh) - 1), Kd = up ? DD : DF;
        char* dst = (char*)(up ? WupT : WdnT) + ((size_t)(64 * nb + 8 * wid) * Kd + 64 * kb) * 2;
        v4u_f w; w.x = cvt_pk_bf16(raw[0], raw[1]); w.y = cvt_pk_bf16(raw[2], raw[3]); w.z = cvt_pk_bf16(raw[4], raw[5]); w.w = cvt_pk_bf16(raw[6], raw[7]);
        *(__attribute__((address_space(1))) v4u_f*)(dst + (unsigned)(lane >> 3) * (unsigned)(Kd * 2) + (unsigned)(lane & 7) * 16u) = w;
    }
};
template <class Epi, class Sched, bool ALIGN_EPI = false, bool SP2 = false, class Fill = NoFill>
__device__ __forceinline__ void gemm_phase(PG8_LAS unsigned char* lds, const Gemm g, const Sched& S, const Epi& E, Fill FL = Fill()) {
    static_assert(!Fill::ON || SP2, "the filler is written for the SP2 loop");
    PG8_LAS unsigned char* fbuf = lds + STAGE_BYTES + (__builtin_amdgcn_readfirstlane(threadIdx.x >> 6)) * 2304;
    const int tid = threadIdx.x, wid = __builtin_amdgcn_readfirstlane(tid >> 6), lane = tid & 63, wr = wid >> 2, wc = wid & 3, fr = lane & 15, fq = lane >> 4;
    const int K = g.ld, nt = g.K / BK;
    unsigned voffA[2], voffB[2];
#pragma unroll
    for (int i = 0; i < 2; ++i) { int R, C; stage_rc(tid * 16 + i * 8192, R, C); const int Rb = Epi::PERM ? ((R & ~31) + perm32(R & 31)) : R;
        voffA[i] = (unsigned)(R * K + C) * 2u; voffB[i] = (unsigned)(Rb * K + C) * 2u; }
    const size_t kstep = (size_t)(BK * 2);
    const size_t hstep = (size_t)HALF * K * 2;
    const size_t tstep = 2 * hstep;
    const unsigned ldsw = (unsigned)wid * 1024u;
    const int aoff = lds_byte(wr * 64 + fr, fq * 8), boff = lds_byte(wc * 32 + fr, fq * 8);
#define PG8_SA(b, h) (((b) * 2 + (h)) * HTB)
#define PG8_SB(b, h) ((4 + (b) * 2 + (h)) * HTB)
#define PG8_STAGE(bufoff, gbase, voff) do { _Pragma("unroll") for (int _i = 0; _i < 2; ++_i) \
        __builtin_amdgcn_global_load_lds((const unsigned*)((const char*)(gbase) + (voff)[_i]), (PG8_LAS unsigned*)(lds + (bufoff) + ldsw + _i * 8192), 16, 0, 0); } while (0)
#define PG8_LDA(dst, b, h) do { _Pragma("unroll") for (int m = 0; m < 4; ++m) _Pragma("unroll") for (int k = 0; k < 2; ++k) dst[m][k] = *(const PG8_LAS bf16x8*)(lds + PG8_SA(b, h) + aoff + m * 2048 + k * 1024); } while (0)
#define PG8_LDB(dst, b, h) do { _Pragma("unroll") for (int n = 0; n < 2; ++n) _Pragma("unroll") for (int k = 0; k < 2; ++k) dst[n][k] = *(const PG8_LAS bf16x8*)(lds + PG8_SB(b, h) + boff + n * 2048 + k * 1024); } while (0)
#define PG8_MMA(ai, bj, At, Bt) do { __builtin_amdgcn_s_setprio(1); _Pragma("unroll") for (int m = 0; m < 4; ++m) _Pragma("unroll") for (int n = 0; n < 2; ++n) _Pragma("unroll") for (int k = 0; k < 2; ++k) \
        acc[ai][bj][m][n] = __builtin_amdgcn_mfma_f32_16x16x32_bf16(Bt[n][k], At[m][k], acc[ai][bj][m][n], 0, 0, 0); __builtin_amdgcn_s_setprio(0); } while (0)
#define PG8_WAIT_V(n) asm volatile("s_waitcnt vmcnt(" #n ")" ::: "memory")
#define PG8_WAIT_L(n) asm volatile("s_waitcnt lgkmcnt(" #n ")" ::: "memory")
#define PG8_BAR __builtin_amdgcn_s_barrier()
#define PG8_SCHED __builtin_amdgcn_sched_barrier(0)
    Unit cur, nxt; int ui = 0;
    if constexpr (Fill::ON) { FL.set_wave(wid); if (FL.fi < FL.fend) FL.issue(FL.fi, fbuf, wid, lane); }
    if (S.next(0, cur)) {
    f32x4 acc[2][2][4][2];
#pragma unroll
    for (int a = 0; a < 2; ++a)
#pragma unroll
        for (int b = 0; b < 2; ++b)
#pragma unroll
            for (int m = 0; m < 4; ++m)
#pragma unroll
                for (int n = 0; n < 2; ++n) acc[a][b][m][n] = (f32x4){0.f, 0.f, 0.f, 0.f};
    bf16x8 At[4][2], B0[2][2], B1[2][2];
    const char* cA = (const char*)g.A + (size_t)cur.pm * tstep + (size_t)cur.k0 * 2; const char* cB = (const char*)g.Bt + (size_t)cur.pn * tstep + (size_t)cur.k0 * 2;
    S.a_ready(cur);
    if constexpr (SP2) {
        PG8_STAGE(PG8_SB(0, 0), cB, voffB); PG8_STAGE(PG8_SB(0, 1), cB + hstep, voffB); PG8_STAGE(PG8_SA(0, 0), cA, voffA); PG8_STAGE(PG8_SA(0, 1), cA + hstep, voffA);
        if (wr == 1) PG8_BAR;
        PG8_WAIT_V(2); PG8_BAR;
        PG8_STAGE(PG8_SB(1, 0), cB + kstep, voffB); PG8_STAGE(PG8_SA(1, 0), cA + kstep, voffA); PG8_STAGE(PG8_SB(1, 1), cB + hstep + kstep, voffB);
        PG8_WAIT_V(6); PG8_BAR;
    } else {
        PG8_STAGE(PG8_SB(0, 0), cB, voffB); PG8_STAGE(PG8_SA(0, 0), cA, voffA); PG8_STAGE(PG8_SB(0, 1), cB + hstep, voffB); PG8_STAGE(PG8_SA(0, 1), cA + hstep, voffA);
        if (wr == 1) PG8_BAR;
        PG8_WAIT_V(4); PG8_BAR;
        PG8_STAGE(PG8_SB(1, 0), cB + kstep, voffB); PG8_STAGE(PG8_SA(1, 0), cA + kstep, voffA); PG8_STAGE(PG8_SB(1, 1), cB + hstep + kstep, voffB);
        PG8_WAIT_V(6); PG8_BAR;
    }
    for (;;) {
        const bool has_next = S.next(ui + 1, nxt);
        const char* nA = has_next ? (const char*)g.A + (size_t)nxt.pm * tstep + (size_t)nxt.k0 * 2 : cA; const char* nB = has_next ? (const char*)g.Bt + (size_t)nxt.pn * tstep + (size_t)nxt.k0 * 2 : cB;
        for (int t = 0; t < nt; t += 2) {
            const bool last = (t == nt - 2);
            const char* a1 = cA + (size_t)(t + 1) * kstep;
            const char* a2 = last ? nA : cA + (size_t)(t + 2) * kstep; const char* b2 = last ? nB : cB + (size_t)(t + 2) * kstep;
            const char* a3 = a2 + kstep; const char* b3 = b2 + kstep;
            if (last && has_next) S.a_ready(nxt);
            if constexpr (SP2) {
            bool fact = false; float fraw[8];
            if constexpr (Fill::ON) { fact = FL.fi < FL.fend; if (fact) { FL.read(fraw, fbuf, lane); PG8_SCHED; } }
            PG8_LDB(B0, 0, 0); PG8_LDB(B1, 0, 1); PG8_SCHED; PG8_LDA(At, 0, 0); PG8_STAGE(PG8_SA(1, 1), a1 + hstep, voffA);
            if constexpr (Fill::ON) { if (fact) { PG8_SCHED; FL.store(fraw, FL.fi, wid, lane); asm volatile("" ::: "memory");
                    const int nf = FL.fi + 1 < FL.fend ? FL.fi + 1 : FL.fi; FL.issue(nf, fbuf, wid, lane); FL.fi += 1; PG8_SCHED; } }
            if (fact) PG8_WAIT_V(17); else PG8_WAIT_V(8);
            PG8_WAIT_L(0); PG8_BAR; PG8_MMA(0, 0, At, B0); PG8_MMA(0, 1, At, B1); PG8_BAR; PG8_SCHED;
            PG8_LDA(At, 0, 1); PG8_STAGE(PG8_SB(0, 0), b2, voffB); PG8_STAGE(PG8_SB(0, 1), b2 + hstep, voffB); PG8_STAGE(PG8_SA(0, 0), a2, voffA);
            if (fact) PG8_WAIT_V(17); else PG8_WAIT_V(8);
            PG8_WAIT_L(0); PG8_BAR; PG8_MMA(1, 0, At, B0); PG8_MMA(1, 1, At, B1); PG8_BAR; PG8_SCHED;
            PG8_LDB(B0, 1, 0); PG8_LDB(B1, 1, 1); PG8_SCHED; PG8_LDA(At, 1, 0); PG8_STAGE(PG8_SA(0, 1), a2 + hstep, voffA);
            if (fact) PG8_WAIT_V(17); else PG8_WAIT_V(8);
            PG8_WAIT_L(0); PG8_BAR; PG8_MMA(0, 0, At, B0); PG8_MMA(0, 1, At, B1); PG8_BAR; PG8_SCHED;
            PG8_LDA(At, 1, 1); PG8_STAGE(PG8_SB(1, 0), b3, voffB); PG8_STAGE(PG8_SB(1, 1), b3 + hstep, voffB); PG8_STAGE(PG8_SA(1, 0), a3, voffA);
            PG8_WAIT_V(8); PG8_WAIT_L(0); PG8_BAR; PG8_MMA(1, 0, At, B0); PG8_MMA(1, 1, At, B1); PG8_BAR; PG8_SCHED;
            } else {
            PG8_LDB(B0, 0, 0); PG8_SCHED; PG8_LDA(At, 0, 0); PG8_STAGE(PG8_SA(1, 1), a1 + hstep, voffA);
            PG8_WAIT_L(8); PG8_BAR; PG8_WAIT_L(0); PG8_MMA(0, 0, At, B0); PG8_BAR; PG8_SCHED;
            PG8_LDB(B1, 0, 1); PG8_STAGE(PG8_SB(0, 0), b2, voffB);
            PG8_BAR; PG8_WAIT_L(0); PG8_MMA(0, 1, At, B1); PG8_BAR;
            PG8_LDA(At, 0, 1); PG8_STAGE(PG8_SA(0, 0), a2, voffA);
            PG8_BAR; PG8_WAIT_L(0); PG8_MMA(1, 0, At, B0); PG8_BAR; PG8_SCHED;
            PG8_STAGE(PG8_SB(0, 1), b2 + hstep, voffB);
            PG8_WAIT_V(6); PG8_BAR; PG8_MMA(1, 1, At, B1); PG8_BAR;
            PG8_LDB(B0, 1, 0); PG8_SCHED; PG8_LDA(At, 1, 0); PG8_STAGE(PG8_SA(0, 1), a2 + hstep, voffA);
            PG8_WAIT_L(8); PG8_BAR; PG8_WAIT_L(0); PG8_MMA(0, 0, At, B0); PG8_BAR; PG8_SCHED;
            PG8_LDB(B1, 1, 1); PG8_STAGE(PG8_SB(1, 0), b3, voffB);
            PG8_BAR; PG8_WAIT_L(0); PG8_MMA(0, 1, At, B1); PG8_BAR;
            PG8_LDA(At, 1, 1); PG8_STAGE(PG8_SA(1, 0), a3, voffA);
            PG8_BAR; PG8_WAIT_L(0); PG8_MMA(1, 0, At, B0); PG8_BAR; PG8_SCHED;
            PG8_STAGE(PG8_SB(1, 1), b3 + hstep, voffB);
            PG8_WAIT_V(6); PG8_BAR; PG8_MMA(1, 1, At, B1); PG8_BAR;
            }
        }
        if constexpr (ALIGN_EPI) { if (wr == 0) PG8_BAR; }
        if constexpr (!Epi::AFTER_DRAIN) { E(acc, cur, wr, wc, fr, fq); S.done(cur); }
        if (!has_next) break;
#pragma unroll
        for (int a = 0; a < 2; ++a)
#pragma unroll
            for (int b = 0; b < 2; ++b)
#pragma unroll
                for (int m = 0; m < 4; ++m)
#pragma unroll
                    for (int n = 0; n < 2; ++n) acc[a][b][m][n] = (f32x4){0.f, 0.f, 0.f, 0.f};
        cur = nxt; cA = nA; cB = nB; ++ui;
        if constexpr (ALIGN_EPI) { if (wr == 1) PG8_BAR; }
    }
    PG8_WAIT_V(0);
    if constexpr (!ALIGN_EPI) { if (wr == 0) PG8_BAR; }
    PG8_BAR;
    if constexpr (Epi::AFTER_DRAIN) { E.fused(acc, cur, wr, wc, fr, fq, lds, wid, lane); S.done(cur); }
    }
    if constexpr (Fill::ON) {
        while (FL.fi < FL.fend) { float fraw[8]; PG8_WAIT_V(0); FL.read(fraw, fbuf, lane); FL.store(fraw, FL.fi, wid, lane); PG8_WAIT_L(0); asm volatile("" ::: "memory");
            FL.fi += 1; if (FL.fi < FL.fend) FL.issue(FL.fi, fbuf, wid, lane); }
        PG8_WAIT_V(0);
    }
#undef PG8_SA
#undef PG8_SB
#undef PG8_STAGE
#undef PG8_LDA
#undef PG8_LDB
#undef PG8_MMA
#undef PG8_WAIT_V
#undef PG8_WAIT_L
#undef PG8_BAR
#undef PG8_SCHED
}
}

constexpr int NWAVES = 8;
#ifndef MK_N_LAUNCHES
#define MK_N_LAUNCHES 1
#endif
#ifndef PROBE_REPEAT
#define PROBE_REPEAT -1
#endif
constexpr int N_LAUNCHES = MK_N_LAUNCHES;
constexpr int N_PHASES = 9;
static_assert(N_LAUNCHES == 1 || N_LAUNCHES == N_PHASES, "MK_N_LAUNCHES is 1 or 9");
#ifndef MIX_SLOW_GATHER
#define MIX_SLOW_GATHER 0
#endif

constexpr int D = 4096, MP = 8192, MS = 1024, M = MP + MS, NPROJ = 12288, NPROJ_PAD = 12544, IN_COLS = 12296, FF = 16384;
constexpr int SEQ = 2048, NB = 4, DECB = 128, DECT = 8, PAST = 16384;
constexpr int HM = 4, DKM = 256, DVM = 512, HR = 8, DKR = 128, DVR = 256;
constexpr float RMS_EPS = 1e-6f, SOFTCAP = 15.f;
constexpr int PC_QM = 0, PC_KM = 1024, PC_VM = 2048, PC_OM = 4096, PC_QR = 6144, PC_KR = 7168, PC_VR = 8192, PC_GR = 10240;
constexpr size_t O_Y = 0, O_PC = 37748736, O_PN = 39845888, O_PM = 39849984, O_PS = 39850000, O_SC = 40898576, O_SN = 108007440, O_SM = 108138512, O_SS = 108139024, O_END = 141693456;
constexpr size_t MiB = 1u << 20;
constexpr size_t WS_CTL = 0, CTL_ZERO_BYTES = 1 * MiB;
constexpr size_t WS_WIN = 2 * MiB, WS_WOUT = 100 * MiB, WS_WUP = 132 * MiB, WS_WDN = 260 * MiB;
constexpr size_t WS_XN = 388 * MiB;
constexpr size_t WS_PROJ = 460 * MiB;
constexpr size_t WS_GATES = 676 * MiB;
constexpr size_t WS_SSQ = 677 * MiB;
constexpr size_t WS_ROPE = 682 * MiB;
constexpr size_t WS_HRAW = 684 * MiB;
constexpr size_t WS_X1B = WS_HRAW;
constexpr size_t WS_CAT = 756 * MiB;
constexpr size_t WS_U = 828 * MiB;
constexpr size_t WS_PART = 1116 * MiB;
constexpr size_t WS_END = 1180 * MiB;
static_assert(WS_WIN + (size_t)NPROJ_PAD * D * 2 <= WS_WOUT && WS_WOUT + (size_t)D * D * 2 <= WS_WUP && WS_WUP + (size_t)FF * D * 2 <= WS_WDN && WS_WDN + (size_t)FF * D * 2 <= WS_XN, "ws map 1");
static_assert(WS_XN + (size_t)M * D * 2 <= WS_PROJ && WS_PROJ + (size_t)M * NPROJ * 2 <= WS_GATES && WS_GATES + (size_t)M * 8 * 4 <= WS_SSQ && WS_SSQ + (size_t)M * 128 * 4 <= WS_ROPE, "ws map 2");
static_assert(WS_ROPE + (size_t)2056 * 64 * 8 <= WS_HRAW && WS_HRAW + (size_t)M * D * 2 <= WS_CAT && WS_CAT + (size_t)M * D * 2 <= WS_U && WS_U + (size_t)M * FF * 2 <= WS_PART && WS_PART + (size_t)4 * MS * D * 4 <= WS_END, "ws map 3");
constexpr int CW_TMO = 0, CW_CODE = 1;
constexpr int CW_BAR = 4096;
constexpr int CW_ROWSSQ = 16384;
constexpr int CW_QUEUE = 8192;
constexpr int LDS_BYTES = 163840;
constexpr int LDSCTL_OFF = 162816, MISC_OFF = LDSCTL_OFF + 320;
static_assert(MISC_OFF + 128 <= LDS_BYTES, "LDS map");

#define GAS __attribute__((address_space(1)))
#define LAS __attribute__((address_space(3)))
typedef unsigned short bf16;
typedef unsigned v4u __attribute__((ext_vector_type(4)));
typedef unsigned v2u __attribute__((ext_vector_type(2)));
typedef float f32x4 __attribute__((ext_vector_type(4)));
typedef float f32x2 __attribute__((ext_vector_type(2)));
typedef short bf16x8 __attribute__((ext_vector_type(8)));
typedef short s16x4 __attribute__((ext_vector_type(4)));
typedef GAS unsigned gu32;
#define RLX_AGENT __ATOMIC_RELAXED, __HIP_MEMORY_SCOPE_AGENT
#define LDS_WAIT() asm volatile("s_waitcnt lgkmcnt(0)" ::: "memory")
#define VM_WAIT() asm volatile("s_waitcnt vmcnt(0)" ::: "memory")
typedef float f32x2_t __attribute__((ext_vector_type(2))); typedef __bf16 bf16x2_t __attribute__((ext_vector_type(2)));
__device__ __forceinline__ unsigned pk2(float lo, float hi) { const f32x2_t v = {lo, hi}; const bf16x2_t b = __builtin_convertvector(v, bf16x2_t); return __builtin_bit_cast(unsigned, b); }
__device__ __forceinline__ float bf_lo(unsigned w) { return __uint_as_float(w << 16); }
__device__ __forceinline__ float bf_hi(unsigned w) { return __uint_as_float(w & 0xffff0000u); }

#define XB_TMO      128
#define XB_XCNT(j)  (256  + 64 * (j))
#define XB_XSUB(j)  (1280 + 64 * (j))
#define XB_XGEN(j)  (2304 + 64 * (j))
#define XB_TOP      3328
#define XB_TOPGEN   3392
#define XCD_BAR_WORDS 3456
#define XB_SPIN_CAP (1u << 18)

__device__ __forceinline__ unsigned xb_ld(unsigned* p)              { return __hip_atomic_load(p, __ATOMIC_RELAXED, __HIP_MEMORY_SCOPE_AGENT); }
__device__ __forceinline__ unsigned xb_add(unsigned* p, unsigned v) { return __hip_atomic_fetch_add(p, v, __ATOMIC_RELAXED, __HIP_MEMORY_SCOPE_AGENT); }
__device__ __forceinline__ unsigned xb_xcc_id() { return (unsigned)__builtin_amdgcn_s_getreg((3 << 11) | 20) & 0xFu; }
#define XB_SPIN(cond, bar) do { unsigned _sp = 0; while (cond) { __builtin_amdgcn_s_sleep(1); \
    if ((++_sp & 255u) == 0u) { if (xb_ld(&(bar)[XB_TMO])) break; if (_sp > XB_SPIN_CAP) { atomicAdd(&(bar)[XB_TMO], 1u); break; } } } } while (0)

struct XcdBarrier {
    unsigned* bar; unsigned x;
    volatile LAS unsigned* st;
};

__device__ __forceinline__ XcdBarrier xcd_barrier_post(unsigned* bar, volatile LAS unsigned* st) {
    XcdBarrier b; b.bar = bar; b.x = xb_xcc_id(); b.st = st;
    if (threadIdx.x == 0) (void)xb_add(&bar[XB_XCNT(b.x)], 1u);
    return b;
}
__device__ __forceinline__ void xcd_barrier_complete(unsigned* bar, unsigned x, unsigned& nloc, unsigned& nx) {
    const unsigned G = gridDim.x * gridDim.y * gridDim.z;
    unsigned sum, cnt, mine, sp = 0u;
    for (;;) {
        sum = 0u; cnt = 0u; mine = 0u;
#pragma unroll
        for (unsigned j = 0; j < 16; ++j) { const unsigned c = xb_ld(&bar[XB_XCNT(j)]); sum += c; cnt += (c > 0u) ? 1u : 0u; mine = (j == x) ? c : mine; }
        if (sum == G) break;
        __builtin_amdgcn_s_sleep(1);
        if ((++sp & 255u) == 0u) { if (xb_ld(&bar[XB_TMO])) break; if (sp > XB_SPIN_CAP) { atomicAdd(&bar[XB_TMO], 1u); break; } }
    }
    nloc = mine > 0u ? mine : 1u; nx = cnt > 0u ? cnt : 1u;
}

__device__ __forceinline__ void xcd_barrier(const XcdBarrier& b) {
    asm volatile("s_waitcnt vmcnt(0)" ::: "memory");
    __syncthreads();
    if (threadIdx.x == 0) {
        unsigned* bar = b.bar;
        __builtin_amdgcn_s_waitcnt(0);
        unsigned nloc = b.st[0], nx = b.st[1];
        if (nloc == 0u) { xcd_barrier_complete(bar, b.x, nloc, nx); b.st[0] = nloc; b.st[1] = nx; }
        const unsigned old = xb_add(&bar[XB_XSUB(b.x)], 1u);
        const unsigned gen = old / nloc;
        if (old + 1u == (gen + 1u) * nloc) {
            __builtin_amdgcn_fence(__ATOMIC_RELEASE, "agent");
            asm volatile("s_waitcnt vmcnt(0)" ::: "memory");
            const unsigned og = xb_add(&bar[XB_TOP], 1u);
            const unsigned tg = og / nx;
            if (og + 1u == (tg + 1u) * nx) xb_add(&bar[XB_TOPGEN], 1u);
            else XB_SPIN(xb_ld(&bar[XB_TOPGEN]) == tg, bar);
            __builtin_amdgcn_fence(__ATOMIC_ACQUIRE, "agent");
            xb_add(&bar[XB_XGEN(b.x)], 1u);
            asm volatile("s_waitcnt vmcnt(0)" ::: "memory");
        } else {
            XB_SPIN(xb_ld(&bar[XB_XGEN(b.x)]) == gen, bar);
            __builtin_amdgcn_fence(__ATOMIC_ACQUIRE, "agent");
            asm volatile("s_waitcnt vmcnt(0)" ::: "memory");
        }
    }
    __syncthreads();
}

struct Frame {
    LAS unsigned char* lds;
    volatile LAS unsigned* MISC;
    gu32* ctl;
    int tid, lane, wave;
    int vcu, G;
    const float* in[17]; float* out; unsigned char* ws;
};
__device__ __forceinline__ float wave_sum(float v) {
#pragma unroll
    for (int o = 1; o < 64; o <<= 1) v += __shfl_xor(v, o);
    return v;
}
__device__ __forceinline__ const float* x_row(const Frame& F, int m) { return m < MP ? F.in[0] + (size_t)m * D : F.in[1] + (size_t)(m - MP) * D; }

__device__ __forceinline__ void p0_transpose_item(const float* W, int ldw, int K, int k0, int src_col0, bf16* WT, int dst_row0, LAS float* scr, int lane) {
#pragma unroll 8
    for (int i = 0; i < 32; ++i) { const int kk = 2 * i + (lane >> 5); scr[kk * 33 + (lane & 31)] = W[(size_t)(k0 + kk) * ldw + src_col0 + (lane & 31)]; }
    LDS_WAIT(); asm volatile("" ::: "memory");
    const int c = lane & 7;
#pragma unroll
    for (int j = 0; j < 4; ++j) { const int n = (lane >> 3) + 8 * j; const LAS float* s = scr + (8 * c) * 33 + n;
        v4u o; o.x = pk2(s[0 * 33], s[1 * 33]); o.y = pk2(s[2 * 33], s[3 * 33]); o.z = pk2(s[4 * 33], s[5 * 33]); o.w = pk2(s[6 * 33], s[7 * 33]);
        *(GAS v4u*)(WT + (size_t)(dst_row0 + n) * K + k0 + 8 * c) = o; }
    LDS_WAIT(); asm volatile("" ::: "memory");
}
template <bool OUT_BF16>
__device__ __forceinline__ void rms_row(const float* xrow, const float* g, void* orow, int lane) {
    const GAS f32x4* xr = (const GAS f32x4*)xrow + lane; const GAS f32x4* gr = (const GAS f32x4*)g + lane;
    f32x4 v[16]; float s = 0.f;
#pragma unroll
    for (int j = 0; j < 16; ++j) { v[j] = xr[64 * j]; s += (v[j].x * v[j].x + v[j].y * v[j].y) + (v[j].z * v[j].z + v[j].w * v[j].w); }
    const float rstd = 1.f / sqrtf(wave_sum(s) * (1.f / D) + RMS_EPS);
#pragma unroll
    for (int j = 0; j < 16; ++j) { const f32x4 o = v[j] * rstd * gr[64 * j];
        if (OUT_BF16) { v2u w; w.x = pk2(o.x, o.y); w.y = pk2(o.z, o.w); ((GAS v2u*)orow)[lane + 64 * j] = w; }
        else ((GAS f32x4*)orow)[lane + 64 * j] = o; }
}
template <bool OUT_BF16>
__device__ __forceinline__ void rms_row_sum(const float* base, const float* part, size_t qstride, float* xsum, const float* g, void* orow, int lane) {
    const GAS f32x4* xr = (const GAS f32x4*)base + lane; const GAS f32x4* pr = (const GAS f32x4*)part + lane; const GAS f32x4* gr = (const GAS f32x4*)g + lane; const size_t q4 = qstride / 4;
    f32x4 v[16]; float s = 0.f;
#pragma unroll
    for (int j = 0; j < 16; ++j) { v[j] = xr[64 * j] + ((pr[64 * j] + pr[q4 + 64 * j]) + (pr[2 * q4 + 64 * j] + pr[3 * q4 + 64 * j])); s += (v[j].x * v[j].x + v[j].y * v[j].y) + (v[j].z * v[j].z + v[j].w * v[j].w); }
    if (xsum) {
#pragma unroll
        for (int j = 0; j < 16; ++j) ((GAS f32x4*)xsum)[lane + 64 * j] = v[j]; }
    const float rstd = 1.f / sqrtf(wave_sum(s) * (1.f / D) + RMS_EPS);
#pragma unroll
    for (int j = 0; j < 16; ++j) { const f32x4 o = v[j] * rstd * gr[64 * j];
        if (OUT_BF16) { v2u w; w.x = pk2(o.x, o.y); w.y = pk2(o.z, o.w); ((GAS v2u*)orow)[lane + 64 * j] = w; }
        else ((GAS f32x4*)orow)[lane + 64 * j] = o; }
}
__device__ __forceinline__ void x1_sample_row(const float* x, const float* part, size_t qstride, const float* g, bf16* x1b, bf16* xn, float* ssq_out, int lane) {
    float s = 0.f;
#pragma unroll
    for (int j = 0; j < 8; ++j) { const int c = lane + 64 * j; f32x4 v0 = *(const GAS f32x4*)(x + 8 * c), v1 = *(const GAS f32x4*)(x + 8 * c + 4);
#pragma unroll
        for (int q = 0; q < 4; ++q) { v0 += *(const GAS f32x4*)(part + q * qstride + 8 * c); v1 += *(const GAS f32x4*)(part + q * qstride + 8 * c + 4); }
        s += (v0.x * v0.x + v0.y * v0.y) + (v0.z * v0.z + v0.w * v0.w) + (v1.x * v1.x + v1.y * v1.y) + (v1.z * v1.z + v1.w * v1.w);
        v4u w; w.x = pk2(v0.x, v0.y); w.y = pk2(v0.z, v0.w); w.z = pk2(v1.x, v1.y); w.w = pk2(v1.z, v1.w); ((GAS v4u*)x1b)[c] = w;
        const f32x4 g0 = *(const GAS f32x4*)(g + 8 * c), g1 = *(const GAS f32x4*)(g + 8 * c + 4); v0 = v0 * g0; v1 = v1 * g1;
        w.x = pk2(v0.x, v0.y); w.y = pk2(v0.z, v0.w); w.z = pk2(v1.x, v1.y); w.w = pk2(v1.z, v1.w); ((GAS v4u*)xn)[c] = w; }
    s = wave_sum(s);
    if (lane == 0) *ssq_out = s;
}
template <bool PART>
__device__ __forceinline__ void final_row(const bf16* xb, const float* part, size_t qstride, const float* g, float* y, int lane) {
    f32x4 v[8][2]; float s = 0.f;
#pragma unroll
    for (int j = 0; j < 8; ++j) { const int c = lane + 64 * j; const v4u w = ((const GAS v4u*)xb)[c];
        v[j][0] = (f32x4){bf_lo(w.x), bf_hi(w.x), bf_lo(w.y), bf_hi(w.y)}; v[j][1] = (f32x4){bf_lo(w.z), bf_hi(w.z), bf_lo(w.w), bf_hi(w.w)};
        if (PART) {
#pragma unroll
            for (int q = 0; q < 4; ++q) { v[j][0] += *(const GAS f32x4*)(part + q * qstride + 8 * c); v[j][1] += *(const GAS f32x4*)(part + q * qstride + 8 * c + 4); } }
        s += (v[j][0].x * v[j][0].x + v[j][0].y * v[j][0].y) + (v[j][0].z * v[j][0].z + v[j][0].w * v[j][0].w) + (v[j][1].x * v[j][1].x + v[j][1].y * v[j][1].y) + (v[j][1].z * v[j][1].z + v[j][1].w * v[j][1].w); }
    const float rstd = 1.f / sqrtf(wave_sum(s) * (1.f / D) + RMS_EPS);
#pragma unroll
    for (int j = 0; j < 8; ++j) { const int c = lane + 64 * j;
        *(GAS f32x4*)(y + 8 * c) = v[j][0] * rstd * *(const GAS f32x4*)(g + 8 * c); *(GAS f32x4*)(y + 8 * c + 4) = v[j][1] * rstd * *(const GAS f32x4*)(g + 8 * c + 4); }
}
__device__ __forceinline__ void frow_load(v2u (&xw)[16], const bf16* xb, int lane) {
#pragma unroll
    for (int j = 0; j < 16; ++j) xw[j] = ((const GAS v2u*)xb)[lane + 64 * j];
}
template <bool PART>
__device__ __forceinline__ void frow_finish(const v2u (&xw)[16], const float* part, size_t qstride, const float* g, float* y, int lane) {
    f32x4 v[16]; float s = 0.f;
#pragma unroll
    for (int j = 0; j < 16; ++j) { v[j] = (f32x4){bf_lo(xw[j].x), bf_hi(xw[j].x), bf_lo(xw[j].y), bf_hi(xw[j].y)};
        if (PART) { const GAS f32x4* p = (const GAS f32x4*)part + lane + 64 * j; const size_t q4 = qstride / 4; v[j] += (p[0] + p[q4]) + (p[2 * q4] + p[3 * q4]); if ((j & 3) == 3) asm volatile("" ::: "memory"); }
        s += (v[j].x * v[j].x + v[j].y * v[j].y) + (v[j].z * v[j].z + v[j].w * v[j].w); }
    const float rstd = 1.f / sqrtf(wave_sum(s) * (1.f / D) + RMS_EPS);
#pragma unroll
    for (int j = 0; j < 16; ++j) { ((GAS f32x4*)y)[lane + 64 * j] = v[j] * rstd * ((const GAS f32x4*)g)[lane + 64 * j]; if ((j & 3) == 3) asm volatile("" ::: "memory"); }
}
__device__ __forceinline__ void sincos_d(float a, float& c, float& s) {
    const double x = (double)a; const double n = rint(x * 0.63661977236758134308);
    double r = fma(-n, 1.57079632679489655800e+00, x); r = fma(-n, 6.12323399573676603587e-17, r);
    const double r2 = r * r;
    double sp = -7.6471637318198164759e-13; sp = fma(sp, r2, 1.6059043836821614599e-10); sp = fma(sp, r2, -2.5052108385441718775e-08); sp = fma(sp, r2, 2.7557319223985890653e-06);
    sp = fma(sp, r2, -1.9841269841269841270e-04); sp = fma(sp, r2, 8.3333333333333333333e-03); sp = fma(sp, r2, -1.6666666666666666667e-01); const double sn = fma(sp * r2, r, r);
    double cp = 4.7794773323873852974e-14; cp = fma(cp, r2, -1.1470745597729724714e-11); cp = fma(cp, r2, 2.0876756987868098979e-09); cp = fma(cp, r2, -2.7557319223985890653e-07);
    cp = fma(cp, r2, 2.4801587301587301587e-05); cp = fma(cp, r2, -1.3888888888888888889e-03); cp = fma(cp, r2, 4.1666666666666666667e-02); cp = fma(cp, r2, -0.5); const double cs = fma(cp, r2, 1.0);
    const int q = (int)n & 3;
    const double ss = (q & 1) ? cs : sn, cc = (q & 1) ? sn : cs;
    s = (float)((q & 2) ? -ss : ss); c = (float)(((q + 1) & 2) ? -cc : cc);
}
__device__ __forceinline__ void p0_prologue(Frame& F) {
    LAS float* scr = (LAS float*)(F.lds + F.wave * 16384);
    const int gw = F.vcu * NWAVES + F.wave, NGW = F.G * NWAVES;
    const float* Win = F.in[6]; const float* Wout = F.in[11]; const float* Wup = F.in[14]; const float* Wdn = F.in[15];
    bf16* WinT = (bf16*)(F.ws + WS_WIN); bf16* WoutT = (bf16*)(F.ws + WS_WOUT); bf16* WupT = (bf16*)(F.ws + WS_WUP); bf16* WdnT = (bf16*)(F.ws + WS_WDN);
    constexpr int I_IN = (D / 64) * (NPROJ / 32), I_OUT = (D / 64) * (D / 32), I_UP = (D / 64) * (FF / 32), I_DN = (FF / 64) * (D / 32);
    constexpr int NITEMS = I_IN + I_OUT;
    for (int it = gw; it < NITEMS; it += NGW) {
        int r = NITEMS - 1 - it;
        if (r < I_IN) { const int nblk = NPROJ / 32, kb = r / nblk, nb = r % nblk, n0 = 32 * nb; p0_transpose_item(Win, IN_COLS, D, 64 * kb, n0 < 6144 ? n0 : n0 + 8, WinT, n0, scr, F.lane); continue; } r -= I_IN;
        { const int nblk = D / 32, kb = r / nblk, nb = r % nblk; p0_transpose_item(Wout, D, D, 64 * kb, 32 * nb, WoutT, 32 * nb, scr, F.lane); }
    }
    { const int gt = (F.vcu * NWAVES + F.wave) * 64 + F.lane, NGT = F.G * NWAVES * 64;
      for (int i = gt; i < 8 * D; i += NGT) { const int n = i / D, k = i % D; WinT[(size_t)(NPROJ + n) * D + k] = (bf16)(pk2(Win[(size_t)k * IN_COLS + 6144 + n], 0.f) & 0xffffu); }
      GAS v4u* z = (GAS v4u*)(WinT + (size_t)(NPROJ + 8) * D); const int nz = (NPROJ_PAD - NPROJ - 8) * D / 8;
      for (int i = gt; i < nz; i += NGT) z[i] = (v4u){0u, 0u, 0u, 0u};
      GAS f32x2* rope = (GAS f32x2*)(F.ws + WS_ROPE);
      for (int i = gt; i < 2056 * 64; i += NGT) { const int pi = i >> 6, j = i & 63; const float pos = (float)(pi < 2048 ? pi : PAST + pi - 2048);
          double fd = 1.0; if (j & 1) fd *= 0.8659643233600653; if (j & 2) fd *= 0.7498942093324559; if (j & 4) fd *= 0.5623413251903491; if (j & 8) fd *= 0.31622776601683794; if (j & 16) fd *= 0.1; if (j & 32) fd *= 0.01;
          const float freq = (float)fd; const float ang = pos * freq; float c, s; sincos_d(ang, c, s); rope[i] = (f32x2){c, s}; }
    }
    bf16* XN = (bf16*)(F.ws + WS_XN);
    for (int m = gw; m < M; m += NGW) rms_row<true>(x_row(F, m), F.in[12], XN + (size_t)m * D, F.lane);
}

__device__ __forceinline__ bf16x8 lds_row8(const LAS bf16* p) { return *(const LAS bf16x8*)p; }
template <int PERM> __device__ __forceinline__ int prow(int r) { return PERM == 1 ? ((r & ~12) | ((r & 4) << 1) | ((r & 8) >> 1)) : PERM == 2 ? ((r & ~7) | ((r & 3) << 1) | ((r >> 2) & 1)) : r; }
template <int PERM>
__device__ __forceinline__ bf16x8 lds_tr8(const LAS bf16* img, int stride, int k0, int c0, int fr, int fq) {
    typedef short v4i16_t __attribute__((ext_vector_type(4)));
    const int q = fr >> 2, p = fr & 3;
    const int rlo = PERM == 1 ? 16 * (fq >> 1) + 4 * (fq & 1) + q : PERM == 2 ? 8 * fq + 2 * q : 8 * fq + q;
    constexpr int dhi = PERM == 1 ? 8 : PERM == 2 ? 1 : 4;
    const LAS bf16* a = img + (k0 + rlo) * stride + c0 + 4 * p;
    const s16x4 lo = __builtin_bit_cast(s16x4, __builtin_amdgcn_ds_read_tr16_b64_v4i16((LAS v4i16_t*)a));
    const s16x4 hi = __builtin_bit_cast(s16x4, __builtin_amdgcn_ds_read_tr16_b64_v4i16((LAS v4i16_t*)(a + dhi * stride)));
    return (bf16x8){lo.x, lo.y, lo.z, lo.w, hi.x, hi.y, hi.z, hi.w};
}
__device__ __forceinline__ f32x4 mfma16(bf16x8 a, bf16x8 b, f32x4 c) { return __builtin_amdgcn_mfma_f32_16x16x32_bf16(a, b, c, 0, 0, 0); }
__device__ __forceinline__ float softcap_f(float z) { const float e = __expf(z * (2.f / SOFTCAP)); return SOFTCAP * (1.f - 2.f / (e + 1.f)); }
__device__ __forceinline__ float logsigmoid_f(float x) { return fminf(x, 0.f) - __logf(1.f + __expf(-fabsf(x))); }
template <bool MAX>
__device__ __forceinline__ float dpp_scan(float v) {
    const int idn = MAX ? (int)0xff800000u : 0;
#define DPP_STEP(ctrl, rmask) do { const float t_ = __builtin_bit_cast(float, __builtin_amdgcn_update_dpp(idn, __builtin_bit_cast(int, v), ctrl, rmask, 0xf, false)); v = MAX ? fmaxf(v, t_) : v + t_; } while (0)
    DPP_STEP(0x111, 0xf); DPP_STEP(0x112, 0xf); DPP_STEP(0x114, 0xf); DPP_STEP(0x118, 0xf);
    DPP_STEP(0x142, 0xa); DPP_STEP(0x143, 0xc);
#undef DPP_STEP
    return v;
}
__device__ __forceinline__ float scan_add(float v, int lane) { (void)lane; return dpp_scan<false>(v); }
__device__ __forceinline__ float scan_max(float v, int lane) { (void)lane; return dpp_scan<true>(v); }
__device__ __forceinline__ void rot8(v4u& a, v4u& b, const GAS f32x4* cs) {
#pragma unroll
    for (int w = 0; w < 4; ++w) { const f32x4 t = cs[w]; const float x1l = bf_lo(a[w]), x1h = bf_hi(a[w]), x2l = bf_lo(b[w]), x2h = bf_hi(b[w]);
        a[w] = pk2(x1l * t.x - x2l * t.y, x1h * t.z - x2h * t.w); b[w] = pk2(x1l * t.y + x2l * t.x, x1h * t.w + x2h * t.z); }
}

__device__ __forceinline__ void rot8v(v4u& a, v4u& b, const f32x4 (&cs)[4]) {
#pragma unroll
    for (int w = 0; w < 4; ++w) { const f32x4 t = cs[w]; const float x1l = bf_lo(a[w]), x1h = bf_hi(a[w]), x2l = bf_lo(b[w]), x2h = bf_hi(b[w]);
        a[w] = pk2(x1l * t.x - x2l * t.y, x1h * t.z - x2h * t.w); b[w] = pk2(x1l * t.y + x2l * t.x, x1h * t.w + x2h * t.z); }
}
template <bool MLSTM, int DBG = 0>
__device__ __forceinline__ void prompt_chain(Frame& F, int unit) {
    constexpr int DK = MLSTM ? DKM : DKR, NDT = MLSTM ? 5 : 4, QS = DK + 16, VS = NDT * 16 + 8, PS = 80, NKT = DK / 128;
    constexpr int L_Q = 0, L_K = L_Q + 64 * QS * 2, L_V = L_K + 64 * QS * 2, L_P = L_V + 64 * VS * 2, L_C = L_P + 64 * PS * 2, L_ARR = L_C + DK * VS * 2;
    static_assert(L_ARR + 2 * 384 * 4 <= LDSCTL_OFF, "prompt chain LDS");
    LAS bf16* Qs = (LAS bf16*)(F.lds + L_Q); LAS bf16* Ks = (LAS bf16*)(F.lds + L_K); LAS bf16* Vx = (LAS bf16*)(F.lds + L_V); LAS bf16* Ps = (LAS bf16*)(F.lds + L_P); LAS bf16* Cb = (LAS bf16*)(F.lds + L_C);
    LAS float* a_g = (LAS float*)(F.lds + L_ARR); LAS float* a_Mx = a_g + 64; LAS float* a_iw = a_g + 128; LAS float* a_emt = a_g + 192; LAS float* a_w = a_g + 256; LAS float* a_sc = a_g + 320;
    int tid = F.tid; asm volatile("" : "+v"(tid));
    const int lane = tid & 63, wave = F.wave, fr = lane & 15, fq = lane >> 4;
    const int NSL = MLSTM ? 8 : 4, NH = MLSTM ? HM : HR;
    const int sl = unit % NSL, h = (unit / NSL) % NH, b = unit / (NSL * NH);
    const int qcol = (MLSTM ? PC_QM : PC_QR) + h * DK, kcol = (MLSTM ? PC_KM : PC_KR) + h * DK, vcol = (MLSTM ? PC_VM + h * DVM : PC_VR + h * DVR) + sl * 64;
    const int hcol = (MLSTM ? h * DVM : HM * DVM + h * DVR) + sl * 64;
    const bf16* proj = (const bf16*)(F.ws + WS_PROJ); const float* gates = (const float*)(F.ws + WS_GATES); bf16* hraw = (bf16*)(F.ws + WS_HRAW);
    float* ssq = (float*)(F.ws + WS_SSQ) + (MLSTM ? 0 : (size_t)M * 64);
    const GAS f32x4* rope = (const GAS f32x4*)(F.ws + WS_ROPE);
    for (int i = tid; i < DK * VS / 2; i += 512) ((LAS unsigned*)Cb)[i] = 0u;
    for (int i = tid; i < 64 * VS / 2; i += 512) ((LAS unsigned*)Vx)[i] = 0u;
    __syncthreads();
    if (MLSTM) { if (tid < 64) Vx[tid * VS + 64] = (bf16)0x3f80; }
    else if (tid < 64) {
        const float lg = logf(1.f - exp2f(-5.f - (float)h)), lsc = -0.5f * logf((float)DKR);
        a_g[tid] = -(float)tid * lg + lsc; a_Mx[tid] = -(float)tid * lg; a_iw[tid] = expf((float)(tid + 1) * lg); a_emt[tid] = 0.f; a_w[tid] = expf((float)(63 - tid) * lg + lsc);
        if (tid == 0) a_sc[0] = expf(64.f * lg);
    }
    f32x4 st[NKT][NDT];
#pragma unroll
    for (int kt = 0; kt < NKT; ++kt)
#pragma unroll
        for (int t = 0; t < NDT; ++t) st[kt][t] = (f32x4){0.f, 0.f, 0.f, 0.f};
    float m_run = 0.f;
    const float bi = MLSTM ? F.in[7][h] : 0.f, bfg = MLSTM ? F.in[8][h] : 0.f;
    v4u pq[4], pk[4], pv; f32x4 pcs[4]; float pig = 0.f, pfg = 0.f;
    const int rA = tid >> 3, cA8 = tid & 7;
#define CHAIN_LOAD(cn) do { const int row0n = b * SEQ + (cn) * 64; \
        if (MLSTM) { _Pragma("unroll") for (int i = 0; i < 4; ++i) { const int id = tid + 512 * i, r = id >> 5, cc = id & 31; \
                pq[i] = *(const GAS v4u*)(proj + (size_t)(row0n + r) * NPROJ + qcol + 8 * cc); pk[i] = *(const GAS v4u*)(proj + (size_t)(row0n + r) * NPROJ + kcol + 8 * cc); } \
            if (wave == 0) { pig = gates[(size_t)(row0n + lane) * 8 + h]; pfg = gates[(size_t)(row0n + lane) * 8 + 4 + h]; } } \
        else { const bf16* pr = proj + (size_t)(row0n + rA) * NPROJ + 8 * cA8; pq[0] = *(const GAS v4u*)(pr + qcol); pq[1] = *(const GAS v4u*)(pr + qcol + 64); pk[0] = *(const GAS v4u*)(pr + kcol); pk[1] = *(const GAS v4u*)(pr + kcol + 64); \
            const GAS f32x4* cs = rope + ((size_t)((cn) * 64 + rA) * 64 + 8 * cA8) / 2; _Pragma("unroll") for (int w = 0; w < 4; ++w) pcs[w] = cs[w]; } \
        pv = *(const GAS v4u*)(proj + (size_t)(row0n + rA) * NPROJ + vcol + 8 * cA8); } while (0)
#define CHAIN_STORE() do { \
        if (MLSTM) { _Pragma("unroll") for (int i = 0; i < 4; ++i) { const int id = tid + 512 * i, r = id >> 5, cc = id & 31; *(LAS v4u*)(Qs + r * QS + 8 * cc) = pq[i]; *(LAS v4u*)(Ks + prow<1>(r) * QS + 8 * cc) = pk[i]; } } \
        else { rot8v(pq[0], pq[1], pcs); rot8v(pk[0], pk[1], pcs); \
            *(LAS v4u*)(Qs + rA * QS + 8 * cA8) = pq[0]; *(LAS v4u*)(Qs + rA * QS + 64 + 8 * cA8) = pq[1]; *(LAS v4u*)(Ks + prow<1>(rA) * QS + 8 * cA8) = pk[0]; *(LAS v4u*)(Ks + prow<1>(rA) * QS + 64 + 8 * cA8) = pk[1]; } \
        *(LAS v4u*)(Vx + prow<2>(rA) * VS + 8 * cA8) = pv; } while (0)
#define CHAIN_GATES(ab) do { \
        const float li = softcap_f(pig + bi), lf = logsigmoid_f(softcap_f(pfg + bfg)); \
        const float bs = scan_add(lf, lane), g = li - bs, Gm = scan_max(g, lane), Mx = fmaxf(m_run, Gm); \
        const float MxL = __shfl(Mx, 63), bL = __shfl(bs, 63); \
        a_g[(ab) + lane] = g; a_Mx[(ab) + lane] = Mx; a_iw[(ab) + lane] = expf(m_run - Mx); a_emt[(ab) + lane] = expf(-(bs + Mx)); a_w[(ab) + lane] = expf(g - MxL); \
        if (lane == 0) a_sc[(ab)] = expf(m_run - MxL); \
        m_run = bL + MxL; } while (0)
    CHAIN_LOAD(0);
    CHAIN_STORE();
    if (MLSTM && wave == 0) CHAIN_GATES(0);
    for (int c = 0; c < SEQ / 64; ++c) {
        const int row0 = b * SEQ + c * 64;
        const int ab = MLSTM ? (c & 1) * 384 : 0, abn = MLSTM ? ((c + 1) & 1) * 384 : 0;
        const bool more = c + 1 < SEQ / 64;
        if (more && !(DBG & 16)) CHAIN_LOAD(c + 1);
        __syncthreads();
        constexpr int NKS = DK / 32;
        const int lt = wave & 3, hf = wave >> 2, l = 16 * lt + fr;
        bf16x8 qf[NKS];
#pragma unroll
        for (int ks = 0; ks < NKS; ++ks) qf[ks] = lds_row8(Qs + l * QS + 32 * ks + 8 * fq);
        if (!(DBG & 1)) {
            const float Mx = a_Mx[ab + l];
            f32x4 acc[2]; acc[0] = (f32x4){0.f, 0.f, 0.f, 0.f}; acc[1] = (f32x4){0.f, 0.f, 0.f, 0.f};
#pragma unroll
            for (int si = 0; si < 2; ++si) { bf16x8 kf[NKS];
#pragma unroll
                for (int ks = 0; ks < NKS; ++ks) kf[ks] = lds_row8(Ks + (16 * (2 * hf + si) + prow<1>(fr)) * QS + 32 * ks + 8 * fq);
#pragma unroll
                for (int ks = 0; ks < NKS; ++ks) acc[si] = mfma16(kf[ks], qf[ks], acc[si]); }
#pragma unroll
            for (int si = 0; si < 2; ++si) { const int stl = 2 * hf + si;
                const f32x4 gv = *(const LAS f32x4*)(a_g + ab + 16 * stl + 4 * fq); float p[4];
#pragma unroll
                for (int r = 0; r < 4; ++r) { const int s_ = 16 * stl + 4 * fq + r; p[r] = (s_ <= l) ? acc[si][r] * __expf(gv[r] - Mx) : 0.f; }
                v2u w; w.x = pk2(p[0], p[1]); w.y = pk2(p[2], p[3]); *(LAS v2u*)(Ps + l * PS + 16 * stl + 4 * fq) = w; }
        }
        if (MLSTM && wave == 0 && more) CHAIN_GATES(abn);
        __syncthreads();
        if (!(DBG & 2)) {
            constexpr int NT = MLSTM ? 3 : 2, NC = NKS / 2;
            f32x4 aQC[NT], aPV[NT];
#pragma unroll
            for (int t = 0; t < NT; ++t) { aQC[t] = (f32x4){0.f, 0.f, 0.f, 0.f}; aPV[t] = (f32x4){0.f, 0.f, 0.f, 0.f}; }
            bf16x8 fs[2][NT][2];
#define DVT(t) (16 * ((t) == 2 ? 4 : 2 * hf + (t)))
#define C_LOAD(set, ch) do { _Pragma("unroll") for (int t = 0; t < NT; ++t) _Pragma("unroll") for (int k = 0; k < 2; ++k) \
                fs[set][t][k] = ((ch) < NC) ? lds_tr8<2>(Cb, VS, 32 * (2 * (ch) + k), DVT(t), fr, fq) : lds_tr8<2>(Vx, VS, 32 * k, DVT(t), fr, fq); } while (0)
            C_LOAD(0, 0); C_LOAD(1, 1);
            const bf16x8 bp0 = lds_row8(Ps + l * PS + 8 * fq), bp1 = lds_row8(Ps + l * PS + 32 + 8 * fq);
            __builtin_amdgcn_sched_barrier(0);
#pragma unroll
            for (int ch = 0; ch <= NC; ++ch) {
                if (ch < NC) {
#pragma unroll
                    for (int k = 0; k < 2; ++k)
#pragma unroll
                        for (int t = 0; t < NT; ++t) aQC[t] = mfma16(fs[ch & 1][t][k], qf[2 * ch + k], aQC[t]);
                } else {
#pragma unroll
                    for (int t = 0; t < NT; ++t) { aPV[t] = mfma16(fs[ch & 1][t][0], bp0, aPV[t]); aPV[t] = mfma16(fs[ch & 1][t][1], bp1, aPV[t]); }
                }
                __builtin_amdgcn_sched_barrier(0);
                if (ch + 2 <= NC) { C_LOAD(ch & 1, ch + 2); __builtin_amdgcn_sched_barrier(0); }
            }
#undef C_LOAD
#undef DVT
            const float iw = a_iw[ab + l]; float inv = 1.f;
            if (MLSTM) { const float den = __shfl(iw * aQC[NT - 1][0] + aPV[NT - 1][0], fr); inv = 1.f / fmaxf(fabsf(den), a_emt[ab + l]); }
            float sq = 0.f;
#pragma unroll
            for (int t = 0; t < 2; ++t) { const f32x4 hv = (iw * aQC[t] + aPV[t]) * inv; sq += (hv.x * hv.x + hv.y * hv.y) + (hv.z * hv.z + hv.w * hv.w);
                v2u w; w.x = pk2(hv.x, hv.y); w.y = pk2(hv.z, hv.w); *(GAS v2u*)(hraw + (size_t)(row0 + l) * D + hcol + 16 * (2 * hf + t) + 4 * fq) = w; }
            sq += __shfl_xor(sq, 16); sq += __shfl_xor(sq, 32);
            if (fq == 0) ssq[(size_t)(row0 + l) * 64 + h * (MLSTM ? 16 : 8) + sl * 2 + hf] = sq;
        }
        if (!(DBG & 4)) {
            const float decay = a_sc[ab];
            bf16x8 bk[NKT][2], av[NDT][2];
#pragma unroll
            for (int t = 0; t < NDT; ++t)
#pragma unroll
                for (int ks = 0; ks < 2; ++ks) av[t][ks] = lds_tr8<2>(Vx, VS, 32 * ks, 16 * t, fr, fq);
#pragma unroll
            for (int ks = 0; ks < 2; ++ks) {
                const f32x4 w0 = *(const LAS f32x4*)(a_w + ab + 32 * ks + 8 * fq), w1 = *(const LAS f32x4*)(a_w + ab + 32 * ks + 8 * fq + 4);
#pragma unroll
                for (int kt = 0; kt < NKT; ++kt) { const bf16x8 raw = lds_tr8<1>(Ks, QS, 32 * ks, 16 * (NKT * wave + kt), fr, fq); v4u pk_;
                    pk_.x = pk2(__uint_as_float((unsigned)(unsigned short)raw[0] << 16) * w0.x, __uint_as_float((unsigned)(unsigned short)raw[1] << 16) * w0.y);
                    pk_.y = pk2(__uint_as_float((unsigned)(unsigned short)raw[2] << 16) * w0.z, __uint_as_float((unsigned)(unsigned short)raw[3] << 16) * w0.w);
                    pk_.z = pk2(__uint_as_float((unsigned)(unsigned short)raw[4] << 16) * w1.x, __uint_as_float((unsigned)(unsigned short)raw[5] << 16) * w1.y);
                    pk_.w = pk2(__uint_as_float((unsigned)(unsigned short)raw[6] << 16) * w1.z, __uint_as_float((unsigned)(unsigned short)raw[7] << 16) * w1.w);
                    bk[kt][ks] = __builtin_bit_cast(bf16x8, pk_); }
            }
#pragma unroll
            for (int kt = 0; kt < NKT; ++kt)
#pragma unroll
                for (int t = 0; t < NDT; ++t) st[kt][t] = st[kt][t] * decay;
#pragma unroll
            for (int ks = 0; ks < 2; ++ks)
#pragma unroll
                for (int t = 0; t < NDT; ++t)
#pragma unroll
                    for (int kt = 0; kt < NKT; ++kt) st[kt][t] = mfma16(av[t][ks], bk[kt][ks], st[kt][t]);
        }
        __syncthreads();
        if (!(DBG & 8))
#pragma unroll
        for (int kt = 0; kt < NKT; ++kt)
#pragma unroll
            for (int t = 0; t < NDT; ++t) { v2u w; w.x = pk2(st[kt][t].x, st[kt][t].y); w.y = pk2(st[kt][t].z, st[kt][t].w);
                *(LAS v2u*)(Cb + (16 * (NKT * wave + kt) + prow<2>(fr)) * VS + 16 * t + 4 * fq) = w; }
        if (more && !(DBG & 16)) CHAIN_STORE();
    }
#undef CHAIN_LOAD
#undef CHAIN_STORE
#undef CHAIN_GATES
    if (MLSTM) {
        float* Co = F.out + O_PC + (size_t)(b * HM + h) * DKM * DVM;
#pragma unroll
        for (int kt = 0; kt < NKT; ++kt) { const int dk = 16 * (NKT * wave + kt) + fr;
#pragma unroll
            for (int t = 0; t < 4; ++t) *(GAS f32x4*)(Co + (size_t)dk * DVM + sl * 64 + 16 * t + 4 * fq) = st[kt][t];
            if (sl == 0 && fq == 0) F.out[O_PN + (size_t)(b * HM + h) * DKM + dk] = st[kt][NDT - 1].x; }
        if (sl == 0 && tid == 0) F.out[O_PM + b * HM + h] = m_run;
    } else {
        float* So = F.out + O_PS + (size_t)(b * HR + h) * DKR * DVR;
#pragma unroll
        for (int kt = 0; kt < NKT; ++kt) { const int dk = 16 * (NKT * wave + kt) + fr;
#pragma unroll
            for (int t = 0; t < 4; ++t) *(GAS f32x4*)(So + (size_t)dk * DVR + sl * 64 + 16 * t + 4 * fq) = st[kt][t]; }
    }
    __syncthreads();
}

struct SuPre { v4u a, b, v; f32x4 cs[4]; float f0, f1, f2, f3; };
template <bool MLSTM>
__device__ __forceinline__ void su_issue(Frame& F, int unit, int tid, SuPre& p) {
    constexpr int DK = MLSTM ? DKM : DKR, DV = MLSTM ? DVM : DVR, NH = MLSTM ? HM : HR;
    const int lane = tid & 63, wave = F.wave, h = unit % NH, b = unit / NH, row0 = MP + b * DECT;
    const int qcol = (MLSTM ? PC_QM : PC_QR) + h * DK, kcol = (MLSTM ? PC_KM : PC_KR) + h * DK, vcol = MLSTM ? PC_VM + h * DVM : PC_VR + h * DVR;
    const bf16* proj = (const bf16*)(F.ws + WS_PROJ); const float* gates = (const float*)(F.ws + WS_GATES);
    if (MLSTM) {
        { const int which = tid >> 8, id = tid & 255, r = id >> 5, cc = id & 31; p.a = *(const GAS v4u*)(proj + (size_t)(row0 + r) * NPROJ + (which ? kcol : qcol) + 8 * cc); }
        { const int r = tid >> 6, cc = tid & 63; p.v = *(const GAS v4u*)(proj + (size_t)(row0 + r) * NPROJ + vcol + 8 * cc); }
        p.f0 = (tid < DK) ? F.in[3][(size_t)(b * HM + h) * DKM + tid] : 0.f;
        if (wave == 7) { const int t = lane & 7; p.f1 = gates[(size_t)(row0 + t) * 8 + h]; p.f2 = gates[(size_t)(row0 + t) * 8 + 4 + h]; p.f3 = F.in[4][b * HM + h]; }
    } else {
        if (tid < 128) { const int which = tid >> 6, id = tid & 63, r = id >> 3, cc = id & 7; const int col = which ? kcol : qcol;
            const GAS f32x4* cs = (const GAS f32x4*)(F.ws + WS_ROPE) + ((size_t)(2048 + r) * 64 + 8 * cc) / 2;
            p.a = *(const GAS v4u*)(proj + (size_t)(row0 + r) * NPROJ + col + 8 * cc); p.b = *(const GAS v4u*)(proj + (size_t)(row0 + r) * NPROJ + col + 64 + 8 * cc);
#pragma unroll
            for (int w = 0; w < 4; ++w) p.cs[w] = cs[w]; }
        if (tid < 256) { const int r = tid >> 5, cc = tid & 31; p.v = *(const GAS v4u*)(proj + (size_t)(row0 + r) * NPROJ + vcol + 8 * cc); }
    }
}
template <bool MLSTM>
__device__ __forceinline__ int sample_unit(Frame& F, int unit, SuPre& p, gu32* qword, unsigned nunits, volatile LAS unsigned* qslot) {
    constexpr int DK = MLSTM ? DKM : DKR, DV = MLSTM ? DVM : DVR, NH = MLSTM ? HM : HR, NCG = DV / 4, NPART = 512 / NCG, RPP = DK / NPART, DPT = DV / 64;
    constexpr int L_QF = 0, L_KF = L_QF + DK * 32, L_KW = L_KF + DK * 32, L_VF = L_KW + DK * 32, L_NF = L_VF + 8 * DV * 4, L_SM = L_NF + DK * 4, L_NP = L_SM + 1024;
    static_assert(L_NP + NPART * 8 * DV * 4 <= LDSCTL_OFF, "sample unit LDS");
    LAS float* qf = (LAS float*)(F.lds + L_QF); LAS float* kf = (LAS float*)(F.lds + L_KF); LAS float* kwf = (LAS float*)(F.lds + L_KW); LAS float* vf = (LAS float*)(F.lds + L_VF);
    LAS float* nf = (LAS float*)(F.lds + L_NF); LAS float* sm = (LAS float*)(F.lds + L_SM); LAS float* np = (LAS float*)(F.lds + L_NP);
    LAS float* s_g = sm, *s_Mx = sm + 8, *s_iw = sm + 16, *s_emt = sm + 24, *s_w = sm + 32, *s_sc = sm + 40, *s_qn = sm + 48, *s_inv = sm + 56, *s_P = sm + 64;
    int tid = F.tid; asm volatile("" : "+v"(tid));
    const int lane = tid & 63, wave = F.wave;
    const int h = unit % NH, b = unit / NH, row0 = MP + b * DECT;
    const int qcol = (MLSTM ? PC_QM : PC_QR) + h * DK, kcol = (MLSTM ? PC_KM : PC_KR) + h * DK, vcol = MLSTM ? PC_VM + h * DVM : PC_VR + h * DVR;
    const int hcol = MLSTM ? h * DVM : HM * DVM + h * DVR;
    const bf16* proj = (const bf16*)(F.ws + WS_PROJ); const float* gates = (const float*)(F.ws + WS_GATES); bf16* hraw = (bf16*)(F.ws + WS_HRAW);
    float* ssq = (float*)(F.ws + WS_SSQ) + (MLSTM ? 0 : (size_t)M * 64);
    const float* S0 = MLSTM ? F.in[2] + (size_t)(b * HM + h) * DKM * DVM : F.in[5] + (size_t)(b * HR + h) * DKR * DVR;
    float* S1 = MLSTM ? F.out + O_SC + (size_t)(b * HM + h) * DKM * DVM : F.out + O_SS + (size_t)(b * HR + h) * DKR * DVR;
    constexpr int QBS = DK + 8; LAS bf16* qb = (LAS bf16*)(F.lds + L_NP); LAS bf16* kb = qb + 8 * QBS;
    if (tid == 0) qslot[0] = __hip_atomic_fetch_add(qword, 1u, RLX_AGENT);
    if (MLSTM) {
        { const int which = tid >> 8, id = tid & 255, r = id >> 5, cc = id & 31; const v4u x = p.a; LAS float* dst = which ? kf : qf;
            *(LAS v4u*)((which ? kb : qb) + r * QBS + 8 * cc) = x;
#pragma unroll
            for (int w = 0; w < 4; ++w) { dst[(8 * cc + 2 * w) * 8 + r] = bf_lo(x[w]); dst[(8 * cc + 2 * w + 1) * 8 + r] = bf_hi(x[w]); } }
    } else {
        if (tid < 128) { const int which = tid >> 6, id = tid & 63, r = id >> 3, cc = id & 7;
            v4u x1 = p.a, x2 = p.b; rot8v(x1, x2, p.cs); LAS float* dst = which ? kf : qf;
            *(LAS v4u*)((which ? kb : qb) + r * QBS + 8 * cc) = x1; *(LAS v4u*)((which ? kb : qb) + r * QBS + 64 + 8 * cc) = x2;
#pragma unroll
            for (int w = 0; w < 4; ++w) { dst[(8 * cc + 2 * w) * 8 + r] = bf_lo(x1[w]); dst[(8 * cc + 2 * w + 1) * 8 + r] = bf_hi(x1[w]);
                dst[(64 + 8 * cc + 2 * w) * 8 + r] = bf_lo(x2[w]); dst[(64 + 8 * cc + 2 * w + 1) * 8 + r] = bf_hi(x2[w]); } }
    }
    if (tid < 8 * DV / 8) { const int r = tid / (DV / 8), cc = tid % (DV / 8); const v4u x = p.v;
#pragma unroll
        for (int w = 0; w < 4; ++w) { vf[r * DV + 8 * cc + 2 * w] = bf_lo(x[w]); vf[r * DV + 8 * cc + 2 * w + 1] = bf_hi(x[w]); } }
    if (MLSTM) { if (tid < DK) nf[tid] = p.f0; }
    if (wave == 7) {
        if (MLSTM) {
            const float m0 = p.f3;
            const float ig = p.f1, fg = p.f2;
            const float li = softcap_f(ig + F.in[7][h]), lf = logsigmoid_f(softcap_f(fg + F.in[8][h]));
            float bs = lf, Gm;
#pragma unroll
            for (int o = 1; o < 8; o <<= 1) { const float tt = __shfl_up(bs, o); if ((lane & 7) >= o) bs += tt; }
            const float g = li - bs; Gm = g;
#pragma unroll
            for (int o = 1; o < 8; o <<= 1) { const float tt = __shfl_up(Gm, o); if ((lane & 7) >= o) Gm = fmaxf(Gm, tt); }
            const float Mx = fmaxf(m0, Gm), MxL = __shfl(Mx, 7), bL = __shfl(bs, 7);
            if (lane < 8) { s_g[lane] = g; s_Mx[lane] = Mx; s_iw[lane] = expf(m0 - Mx); s_emt[lane] = expf(-(bs + Mx)); s_w[lane] = expf(g - MxL); }
            if (lane == 0) { s_sc[0] = expf(m0 - MxL); F.out[O_SM + b * HM + h] = bL + MxL; }
        } else if (lane < 8) {
            const float lg = logf(1.f - exp2f(-5.f - (float)h)), lsc = -0.5f * logf((float)DKR);
            s_g[lane] = -(float)lane * lg + lsc; s_Mx[lane] = -(float)lane * lg; s_iw[lane] = expf((float)(lane + 1) * lg); s_emt[lane] = 0.f; s_w[lane] = expf((float)(7 - lane) * lg + lsc);
            if (lane == 0) s_sc[0] = expf(8.f * lg);
        }
    }
    __syncthreads();
    if (wave == 0) {
        const int fr = lane & 15, fq = lane >> 4; const bf16x8 z8 = (bf16x8){0, 0, 0, 0, 0, 0, 0, 0}; f32x4 d = (f32x4){0.f, 0.f, 0.f, 0.f};
#pragma unroll
        for (int ks = 0; ks < DK / 32; ++ks) { const bf16x8 a = lds_row8(qb + (fr & 7) * QBS + 32 * ks + 8 * fq), bb = lds_row8(kb + (fr & 7) * QBS + 32 * ks + 8 * fq);
            d = mfma16(fr < 8 ? a : z8, fr < 8 ? bb : z8, d); }
        if (fr < 8 && fq < 2) {
#pragma unroll
            for (int r = 0; r < 4; ++r) { const int l = 4 * fq + r; s_P[l * 8 + fr] = (fr <= l) ? d[r] * __expf(s_g[fr] - s_Mx[l]) : 0.f; } }
    }
    for (int i = tid; i < DK * 8; i += 512) kwf[i] = kf[i] * s_w[i & 7];
    if (MLSTM) { float a = 0.f; for (int dk = lane; dk < DK; dk += 64) a += qf[dk * 8 + wave] * nf[dk]; a = wave_sum(a); if (lane == 0) s_qn[wave] = a; }
    __syncthreads();
    const unsigned un = qslot[0];
    if (un < nunits) su_issue<MLSTM>(F, (int)un, tid, p);
    if (MLSTM) {
        if (tid < 8) { float den = s_iw[tid] * s_qn[tid]; for (int s = 0; s < 8; ++s) den += s_P[tid * 8 + s]; s_inv[tid] = 1.f / fmaxf(fabsf(den), s_emt[tid]); }
        if (tid < DK) { float a = s_sc[0] * nf[tid]; for (int s = 0; s < 8; ++s) a += kwf[tid * 8 + s]; F.out[O_SN + (size_t)(b * HM + h) * DKM + tid] = a; }
    } else if (tid < 8) s_inv[tid] = 1.f;
    {
        const int part = __builtin_amdgcn_readfirstlane(tid / NCG), cg = tid % NCG; const float decay = s_sc[0];
        f32x4 vv[8], num[8];
#pragma unroll
        for (int s = 0; s < 8; ++s) { vv[s] = *(const LAS f32x4*)(vf + s * DV + 4 * cg); num[s] = (f32x4){0.f, 0.f, 0.f, 0.f}; }
        const GAS char* srcb = (const GAS char*)(S0 + (size_t)(part * RPP) * DV); GAS char* dstb = (GAS char*)(S1 + (size_t)(part * RPP) * DV); const unsigned vo = (unsigned)cg * 16u;
#define SU_LOAD(buf, r0) do { _Pragma("unroll") for (int j = 0; j < 4; ++j) buf[j] = __builtin_nontemporal_load((const GAS f32x4*)(srcb + (size_t)((r0) + j) * (DV * 4) + vo)); } while (0)
#define SU_COMP(buf, r0) do { _Pragma("unroll") for (int j = 0; j < 4; ++j) { const int dk = part * RPP + (r0) + j; \
                const f32x4 q0 = *(const LAS f32x4*)(qf + dk * 8), q1 = *(const LAS f32x4*)(qf + dk * 8 + 4), k0 = *(const LAS f32x4*)(kwf + dk * 8), k1 = *(const LAS f32x4*)(kwf + dk * 8 + 4); \
                const f32x4 c0 = buf[j]; f32x4 cn = c0 * decay; \
                num[0] += q0.x * c0; num[1] += q0.y * c0; num[2] += q0.z * c0; num[3] += q0.w * c0; num[4] += q1.x * c0; num[5] += q1.y * c0; num[6] += q1.z * c0; num[7] += q1.w * c0; \
                cn += k0.x * vv[0]; cn += k0.y * vv[1]; cn += k0.z * vv[2]; cn += k0.w * vv[3]; cn += k1.x * vv[4]; cn += k1.y * vv[5]; cn += k1.z * vv[6]; cn += k1.w * vv[7]; \
                __builtin_nontemporal_store(cn, (GAS f32x4*)(dstb + (size_t)((r0) + j) * (DV * 4) + vo)); } } while (0)
        static_assert(RPP % 4 == 0 && RPP >= 8, "sample unit row batches");
        f32x4 ca[4], cb[4], cc[4];
        SU_LOAD(ca, 0); SU_LOAD(cb, 4);
        for (int i0 = 0; i0 < RPP; i0 += 12) {
            if (i0 + 8 < RPP) SU_LOAD(cc, i0 + 8);
            SU_COMP(ca, i0);
            if (i0 + 12 < RPP) SU_LOAD(ca, i0 + 12);
            if (i0 + 4 < RPP) SU_COMP(cb, i0 + 4);
            if (i0 + 16 < RPP) SU_LOAD(cb, i0 + 16);
            if (i0 + 8 < RPP) SU_COMP(cc, i0 + 8);
        }
#undef SU_LOAD
#undef SU_COMP
#pragma unroll
        for (int l = 0; l < 8; ++l) *(LAS f32x4*)(np + (size_t)(part * 8 + l) * DV + 4 * cg) = num[l];
    }
    __syncthreads();
    { const int l = wave, dv0 = lane * DPT; const float iw = s_iw[l], inv = s_inv[l]; float hv[DPT]; float sq = 0.f;
#pragma unroll
      for (int j = 0; j < DPT; ++j) { float a = 0.f;
#pragma unroll
          for (int p = 0; p < NPART; ++p) a += np[(size_t)(p * 8 + l) * DV + dv0 + j];
          a *= iw;
#pragma unroll
          for (int s = 0; s < 8; ++s) a += s_P[l * 8 + s] * vf[s * DV + dv0 + j];
          a *= inv; hv[j] = a; sq += a * a; }
      bf16* o = hraw + (size_t)(row0 + l) * D + hcol + dv0;
      if (DPT == 8) { v4u w; w.x = pk2(hv[0], hv[1]); w.y = pk2(hv[2], hv[3]); w.z = pk2(hv[4], hv[5]); w.w = pk2(hv[6], hv[7]); *(GAS v4u*)o = w; }
      else { v2u w; w.x = pk2(hv[0], hv[1]); w.y = pk2(hv[2], hv[3]); *(GAS v2u*)o = w; }
      sq = wave_sum(sq);
      constexpr int NSLOT = MLSTM ? 16 : 8;
      if (lane < NSLOT) ssq[(size_t)(row0 + l) * 64 + h * NSLOT + lane] = (lane == 0) ? sq : 0.f; }
    __syncthreads();
    return un < nunits ? (int)un : -1;
}
template <bool MLSTM>
__device__ __forceinline__ void sample_loop(Frame& F, gu32* qword, unsigned nunits, volatile LAS unsigned* qslot) {
    if (F.tid == 0) qslot[0] = __hip_atomic_fetch_add(qword, 1u, RLX_AGENT);
    __syncthreads();
    int u = (int)qslot[0];
    __syncthreads();
    if ((unsigned)u >= nunits) return;
    SuPre p; su_issue<MLSTM>(F, u, F.tid, p);
    while (u >= 0) u = sample_unit<MLSTM>(F, u, p, qword, nunits, qslot);
}

#ifndef P2_STREAM_ONLY_MOD
#define P2_STREAM_ONLY_MOD 0
#endif
__device__ __forceinline__ void p2_mixers(Frame& F, int rep) {
    volatile LAS unsigned* qslot = F.MISC + 16;
#ifdef CHAIN_DBG
    if (rep == 1) {
        for (;;) {
            if (F.tid == 0) qslot[0] = __hip_atomic_fetch_add(F.ctl + CW_QUEUE + 64 * 3, 1u, RLX_AGENT);
            __syncthreads();
            const unsigned u = qslot[0];
            __syncthreads();
            if (u >= 256u) break;
            if (u < 128u) prompt_chain<true, CHAIN_DBG>(F, (int)u); else prompt_chain<false, CHAIN_DBG>(F, (int)u - 128);
        }
        return;
    }
#endif
    const bool chain_ok = (P2_STREAM_ONLY_MOD == 0) || ((int)blockIdx.x % (P2_STREAM_ONLY_MOD ? P2_STREAM_ONLY_MOD : 1)) != 0;
    if (chain_ok && !(PROBE_REPEAT == 21 && rep == 1)) for (;;) {
        if (F.tid == 0) qslot[0] = __hip_atomic_fetch_add(F.ctl + CW_QUEUE + 64 * (2 + rep), 1u, RLX_AGENT);
        __syncthreads();
        const unsigned u = qslot[0];
        __syncthreads();
        if (u >= 256u) break;
        if (u < 128u) prompt_chain<true>(F, (int)u); else prompt_chain<false>(F, (int)u - 128);
    }
    sample_loop<true>(F, F.ctl + CW_QUEUE + 64 * rep, 512u, qslot);
    sample_loop<false>(F, F.ctl + CW_QUEUE + 64 * (4 + rep), 1024u, qslot);
}

__device__ __forceinline__ void p3_norm_gate(Frame& F) {
    const int gw = F.vcu * NWAVES + F.wave, NGW = F.G * NWAVES, lane = F.lane;
    const bf16* proj = (const bf16*)(F.ws + WS_PROJ); const bf16* hraw = (const bf16*)(F.ws + WS_HRAW); bf16* cat = (bf16*)(F.ws + WS_CAT);
    const float* ssq_m = (const float*)(F.ws + WS_SSQ); const float* ssq_r = ssq_m + (size_t)M * 64;
    f32x4 gg[8][2];
#pragma unroll
    for (int i = 0; i < 8; ++i) { const int col = 8 * lane + 512 * i; const float* gp = (i < 4) ? F.in[9] + col : F.in[10] + (col - 2048); gg[i][0] = *(const GAS f32x4*)gp; gg[i][1] = *(const GAS f32x4*)(gp + 4); }
    for (int m = gw; m < M; m += NGW) {
        float sm = ssq_m[(size_t)m * 64 + lane], sr = ssq_r[(size_t)m * 64 + lane];
        v4u hx[8], gx[8];
#pragma unroll
        for (int i = 0; i < 8; ++i) { const int col = 8 * lane + 512 * i; hx[i] = *(const GAS v4u*)(hraw + (size_t)m * D + col); gx[i] = *(const GAS v4u*)(proj + (size_t)m * NPROJ + (i < 4 ? PC_OM + col : PC_GR + (col - 2048))); }
        sm += __shfl_xor(sm, 1); sm += __shfl_xor(sm, 2); sm += __shfl_xor(sm, 4); sm += __shfl_xor(sm, 8);
        sr += __shfl_xor(sr, 1); sr += __shfl_xor(sr, 2); sr += __shfl_xor(sr, 4);
        const float rm = 1.f / sqrtf(sm * (1.f / DVM) + RMS_EPS), rr = 1.f / sqrtf(sr * (1.f / DVR) + RMS_EPS);
#pragma unroll
        for (int i = 0; i < 8; ++i) {
            const int col = 8 * lane + 512 * i;
            float rs;
            if (i < 4) rs = __shfl(rm, 16 * i);
            else { const float r0 = __shfl(rr, 16 * (i - 4)), r1 = __shfl(rr, 16 * (i - 4) + 8); rs = lane < 32 ? r0 : r1; }
            const float g8[8] = {gg[i][0].x, gg[i][0].y, gg[i][0].z, gg[i][0].w, gg[i][1].x, gg[i][1].y, gg[i][1].z, gg[i][1].w};
            v4u o;
#pragma unroll
            for (int w = 0; w < 4; ++w) { const float h0 = bf_lo(hx[i][w]), h1 = bf_hi(hx[i][w]), z0 = bf_lo(gx[i][w]), z1 = bf_hi(gx[i][w]);
                const float s0 = 1.f / (1.f + __expf(-z0)), s1 = 1.f / (1.f + __expf(-z1));
                const float a0 = (i < 4) ? s0 : z0 * s0, a1 = (i < 4) ? s1 : z1 * s1;
                o[w] = pk2(h0 * rs * g8[2 * w] * a0, h1 * rs * g8[2 * w + 1] * a1); }
            *(GAS v4u*)(cat + (size_t)m * D + col) = o;
        }
    }
}

struct Args { const float* in[17]; float* out; unsigned char* ws; int ph_lo, ph_hi; };
__global__ void __launch_bounds__(NWAVES * 64, 2) hymba_fwd(Args args) {
    extern __shared__ __attribute__((aligned(16))) unsigned char lds[];
    Frame F;
    F.lds = (LAS unsigned char*)lds;
    F.MISC = (volatile LAS unsigned*)(F.lds + MISC_OFF);
    F.tid = threadIdx.x; F.lane = F.tid & 63; F.wave = __builtin_amdgcn_readfirstlane(F.tid >> 6);
    F.G = gridDim.x; { const int bx = blockIdx.x; F.vcu = (F.G % 8 == 0) ? (bx % 8) * (F.G / 8) + bx / 8 : bx; }
#pragma unroll
    for (int i = 0; i < 17; ++i) F.in[i] = args.in[i];
    F.out = args.out; F.ws = args.ws;
    F.ctl = (gu32*)(F.ws + WS_CTL);
    for (int u = F.tid; u < (LDS_BYTES - LDSCTL_OFF) / 4; u += NWAVES * 64) ((LAS unsigned*)(F.lds + LDSCTL_OFF))[u] = 0u;
    __syncthreads();
    XcdBarrier bar; bar.bar = (unsigned*)(F.ctl + CW_BAR); bar.x = 0; bar.st = nullptr;
    if (N_LAUNCHES == 1) bar = xcd_barrier_post((unsigned*)(F.ctl + CW_BAR), F.MISC + 8);
#define GRID_BAR() do { if (N_LAUNCHES == 1) xcd_barrier(bar); } while (0)
    const int lo = args.ph_lo, hi = args.ph_hi;
#define IN(k) (lo <= (k) && (k) < hi)
#define BOTH(k) (IN(k) && IN((k) + 1))
    bf16* XN = (bf16*)(F.ws + WS_XN);
#define RUN2(k, body) do { body; if (PROBE_REPEAT == (k)) { GRID_BAR(); body; } } while (0)
    if (IN(0)) { RUN2(0, p0_prologue(F)); if (BOTH(0)) GRID_BAR(); }
    if (IN(1)) {
        pg8::Gemm g{XN, (const bf16*)(F.ws + WS_WIN), M, NPROJ_PAD, D, D}; pg8::StaticOrder S; S.init(M, NPROJ_PAD, F.G, (int)blockIdx.x);
        pg8::EpiProj E{(bf16*)(F.ws + WS_PROJ), NPROJ, (float*)(F.ws + WS_GATES), NPROJ / 256, 4, 0.0625f};
        typedef pg8::WFill<D, FF> WF; const int f0 = (int)((long long)F.vcu * WF::NI / F.G), f1 = (int)((long long)(F.vcu + 1) * WF::NI / F.G);
        WF FL{F.in[14], F.in[15], (bf16*)(F.ws + WS_WUP), (bf16*)(F.ws + WS_WDN), __builtin_amdgcn_readfirstlane(f0), __builtin_amdgcn_readfirstlane(f1),
              __builtin_amdgcn_readfirstlane(f0), __builtin_amdgcn_readfirstlane(f1 - f0), __builtin_amdgcn_readfirstlane(f1 > f0 ? (F.vcu * 37) % (f1 - f0) : 0)};
        RUN2(1, (pg8::gemm_phase<pg8::EpiProj, pg8::StaticOrder, true, true, WF>(F.lds, g, S, E, FL)));
        if (BOTH(1)) GRID_BAR();
    }
    if (IN(2)) {
#ifdef CHAIN_DBG
        p2_mixers(F, 1); GRID_BAR();
#endif
        p2_mixers(F, 0); if (PROBE_REPEAT == 2 || PROBE_REPEAT == 21) { GRID_BAR(); p2_mixers(F, 1); } if (BOTH(2)) GRID_BAR(); }
    if (IN(3)) { RUN2(3, p3_norm_gate(F)); if (BOTH(3)) GRID_BAR(); }
    bf16* X1B = (bf16*)(F.ws + WS_X1B); float* rowssq = (float*)(F.ws + WS_CTL) + CW_ROWSSQ;
    if (IN(4)) {
        pg8::Gemm g{(const bf16*)(F.ws + WS_CAT), (const bf16*)(F.ws + WS_WOUT), MP, D, D, D}; pg8::StaticOrder S; S.init(MP, D, F.G, (int)blockIdx.x);
        pg8::EpiX1 E{F.in[0], F.in[13], X1B, XN, D, D, rowssq};
        pg8::Gemm g2{(const bf16*)(F.ws + WS_CAT), (const bf16*)(F.ws + WS_WOUT), M, D, D / 4, D}; pg8::SplitTailOrder S2{MP / 256, D / 4, F.G, (int)blockIdx.x};
        pg8::EpiPartF32 E2{(float*)(F.ws + WS_PART), D, MP / 256, D / 4, (size_t)MS * D};
        pg8::gemm_phase<pg8::EpiX1, pg8::StaticOrder, true, true>(F.lds, g, S, E);
        pg8::gemm_phase<pg8::EpiPartF32, pg8::SplitTailOrder, true, true>(F.lds, g2, S2, E2);
        if (BOTH(4)) GRID_BAR();
    }
    if (IN(5)) { const int gw = F.vcu * NWAVES + F.wave, NGW = F.G * NWAVES;
        for (int m = MP + gw; m < M; m += NGW) x1_sample_row(F.in[1] + (size_t)(m - MP) * D, (const float*)(F.ws + WS_PART) + (size_t)(m - MP) * D, (size_t)MS * D, F.in[13], X1B + (size_t)m * D, XN + (size_t)m * D, rowssq + m, F.lane);
        if (BOTH(5)) GRID_BAR(); }
    if (IN(6)) {
        pg8::Gemm g{XN, (const bf16*)(F.ws + WS_WUP), M, FF, D, D}; pg8::StaticOrder S; S.init(M, FF, F.G, (int)blockIdx.x);
        pg8::EpiRelu2S E{(bf16*)(F.ws + WS_U), FF, rowssq, 1.f / D, RMS_EPS};
        pg8::gemm_phase<pg8::EpiRelu2S, pg8::StaticOrder, true, true>(F.lds, g, S, E);
        if (BOTH(6)) GRID_BAR();
    }
    if (IN(7)) {
        pg8::Gemm g{(const bf16*)(F.ws + WS_U), (const bf16*)(F.ws + WS_WDN), MP, D, FF, FF}; pg8::StaticOrder S; S.init(MP, D, F.G, (int)blockIdx.x);
        pg8::EpiX2 E{X1B, D};
        pg8::Gemm g2{(const bf16*)(F.ws + WS_U), (const bf16*)(F.ws + WS_WDN), M, D, FF / 4, FF}; pg8::SplitTailOrder S2{MP / 256, FF / 4, F.G, (int)blockIdx.x};
        pg8::EpiPartF32 E2{(float*)(F.ws + WS_PART), D, MP / 256, FF / 4, (size_t)MS * D};
        pg8::gemm_phase<pg8::EpiX2, pg8::StaticOrder, true, true>(F.lds, g, S, E);
        pg8::gemm_phase<pg8::EpiPartF32, pg8::SplitTailOrder, true, true>(F.lds, g2, S2, E2);
        if (BOTH(7)) GRID_BAR();
    }
    if (IN(8)) { const int gw = F.vcu * NWAVES + F.wave, NGW = F.G * NWAVES; const float* gfin = F.in[16]; const float* partb = (const float*)(F.ws + WS_PART);
        for (int rep8 = 0; rep8 < (PROBE_REPEAT == 8 ? 2 : 1); ++rep8) {
        v2u cur[16], nxt[16];
        if (NGW == 2048) {
            int r0, nr;
            if (gw < 1024) { const int m = MP + gw; frow_load(cur, X1B + (size_t)m * D, F.lane); frow_finish<true>(cur, partb + (size_t)(m - MP) * D, (size_t)MS * D, gfin, F.out + O_Y + (size_t)m * D, F.lane); r0 = 2 * gw; nr = 2; }
            else { r0 = 2048 + (gw - 1024) * 6; nr = 6; }
            frow_load(cur, X1B + (size_t)r0 * D, F.lane);
            for (int i = 0; i < nr; ++i) { const int m = r0 + i;
                if (i + 1 < nr) frow_load(nxt, X1B + (size_t)(m + 1) * D, F.lane);
                frow_finish<false>(cur, nullptr, 0, gfin, F.out + O_Y + (size_t)m * D, F.lane);
#pragma unroll
                for (int j = 0; j < 16; ++j) cur[j] = nxt[j]; }
        } else {
            for (int m = gw; m < M; m += NGW) { frow_load(cur, X1B + (size_t)m * D, F.lane);
                if (m < MP) frow_finish<false>(cur, nullptr, 0, gfin, F.out + O_Y + (size_t)m * D, F.lane);
                else frow_finish<true>(cur, partb + (size_t)(m - MP) * D, (size_t)MS * D, gfin, F.out + O_Y + (size_t)m * D, F.lane); }
        } } }
#undef RUN2
#undef IN
#undef BOTH
}

extern "C" void kernel_launch(void* const* d_in, const int* in_sizes, int n_in, void* d_out, int out_size, void* d_ws, size_t ws_size, hipStream_t stream) {
    static int grid = 0;
    if (grid == 0) {
        if (n_in != 17 || in_sizes[0] != MP * D || (size_t)out_size != O_END || ws_size < WS_END) { fprintf(stderr, "kernel_launch: unexpected shapes: n_in %d in0 %d out %d ws %zu (need %zu); nothing launched\n", n_in, n_in > 0 ? in_sizes[0] : -1, out_size, ws_size, (size_t)WS_END); grid = -1; return; }
        int dev = 0, cus = 0, per_cu = 0;
        if (hipGetDevice(&dev) != hipSuccess || hipDeviceGetAttribute(&cus, hipDeviceAttributeMultiprocessorCount, dev) != hipSuccess) { fprintf(stderr, "kernel_launch: device query failed\n"); grid = -1; return; }
        if (hipFuncSetAttribute((const void*)hymba_fwd, hipFuncAttributeMaxDynamicSharedMemorySize, LDS_BYTES) != hipSuccess) { fprintf(stderr, "kernel_launch: hipFuncSetAttribute(%d B LDS) failed\n", LDS_BYTES); grid = -1; return; }
        if (hipOccupancyMaxActiveBlocksPerMultiprocessor(&per_cu, (const void*)hymba_fwd, NWAVES * 64, LDS_BYTES) != hipSuccess || per_cu < 1)
            fprintf(stderr, "kernel_launch: note: occupancy query reports %d workgroups per CU\n", per_cu);
        (void)hipGetLastError();
        grid = cus;
    }
    if (grid < 0) return;
    if (hipMemsetAsync((char*)d_ws + WS_CTL, 0, CTL_ZERO_BYTES, stream) != hipSuccess) { fprintf(stderr, "kernel_launch: memset failed\n"); return; }
    Args a{};
    for (int i = 0; i < 17; ++i) a.in[i] = (const float*)d_in[i];
    a.out = (float*)d_out; a.ws = (unsigned char*)d_ws;
    for (int li = 0; li < N_LAUNCHES; ++li) {
        a.ph_lo = (N_LAUNCHES == 1) ? 0 : li; a.ph_hi = (N_LAUNCHES == 1) ? N_PHASES : li + 1;
        hipLaunchKernelGGL(hymba_fwd, dim3(grid), dim3(NWAVES * 64), LDS_BYTES, stream, a);
        const hipError_t le = hipPeekAtLastError();
        if (le != hipSuccess) { fprintf(stderr, "kernel_launch: launch %d failed: %s\n", li, hipGetErrorName(le)); break; }
    }
}
```
